# Optimizing an MI355X kernel written in HIP

```python
import math
import jax, jax.numpy as jnp
from jax import lax
import numpy as np

D_MODEL = 2048
BATCH = 2
SEQ = 8192
DEPTH = 2
DEC_BATCH = 16
DEC_SEQ = 64
PAST_LEN = 4096

CHUNK = 64
N_A = DEPTH // 2
N_B = DEPTH - N_A
CONV_W = 3
CONV_DIM = 3 * D_MODEL // 4
HEAD_DIM = 128
N_HEADS_F = CONV_DIM // HEAD_DIM
F_DIM = N_HEADS_F * HEAD_DIM
N_MEM = 256
N_HEADS_M = 4
M_DIM = N_HEADS_M * HEAD_DIM
Q_BLOCK = 128
IN_A = 4 * CONV_DIM + 2 * M_DIM
IN_B = 2 * F_DIM + 2 * M_DIM
MIX_DIM = CONV_DIM + M_DIM
KVF_DIM = 2 * F_DIM + N_HEADS_F
EPS = 1e-6

kernel_name = 'yoco_conv_fox_memory_stream_step'


def rmsnorm(x, g):
    xf = x.astype(jnp.float32)
    y = xf * lax.rsqrt(jnp.mean(xf * xf, axis=-1, keepdims=True) + EPS)
    return (y * g.astype(jnp.float32)).astype(x.dtype)


def causal_depthwise_conv(u, state, w):
    up = jnp.concatenate([state.astype(u.dtype), u], axis=1)
    y = lax.conv_general_dilated(up, w.astype(u.dtype)[:, None, :], window_strides=(1,),
                                 padding='VALID', dimension_numbers=('NWC', 'WIO', 'NWC'),
                                 feature_group_count=u.shape[-1])
    return y, up[:, -(CONV_W - 1):]


def memory_kv(mem, g, w):
    b, n = mem.shape[0], mem.shape[1]
    k, v = jnp.split(rmsnorm(mem, g) @ w, 2, axis=-1)
    return k.reshape(b, n, N_HEADS_M, HEAD_DIM), v.reshape(b, n, N_HEADS_M, HEAD_DIM)


def memory_attention(q, mk, mv):
    s = jnp.einsum('bthd,bmhd->bhtm', q, mk.astype(q.dtype),
                   preferred_element_type=jnp.float32) / math.sqrt(HEAD_DIM)
    p = jax.nn.softmax(s, axis=-1)
    return jnp.einsum('bhtm,bmhd->bthd', p.astype(q.dtype), mv.astype(q.dtype))


def fox_block(q, k, v, c_q, c_k, pos_q, pos_k):
    s = jnp.einsum('bqhd,bkhd->bhqk', q, k.astype(q.dtype),
                   preferred_element_type=jnp.float32) / math.sqrt(HEAD_DIM)
    decay = jnp.swapaxes(c_q, 1, 2)[..., :, None] - jnp.swapaxes(c_k, 1, 2)[..., None, :]
    mask = pos_k[None, :] <= pos_q[:, None]
    s = jnp.where(mask, s + decay, -jnp.inf)
    p = jax.nn.softmax(s, axis=-1)
    return jnp.einsum('bhqk,bkhd->bqhd', p.astype(q.dtype), v.astype(q.dtype))


def forgetting_attention(q, k_all, v_all, c_all, past_len):
    bsz, t = q.shape[0], q.shape[1]
    tk = k_all.shape[1]
    pos_k = jnp.arange(tk)
    pos_q = past_len + jnp.arange(t)
    c_q = c_all[:, past_len:]
    if t <= Q_BLOCK:
        return fox_block(q, k_all, v_all, c_q, c_all, pos_q, pos_k)
    nb = t // Q_BLOCK
    qb = q.reshape(bsz, nb, Q_BLOCK, N_HEADS_F, HEAD_DIM).transpose(1, 0, 2, 3, 4)
    cb = c_q.reshape(bsz, nb, Q_BLOCK, N_HEADS_F).transpose(1, 0, 2, 3)
    pb = pos_q.reshape(nb, Q_BLOCK)
    out = lax.map(lambda a: fox_block(a[0], k_all, v_all, a[1], c_all, a[2], pos_k), (qb, cb, pb))
    return out.transpose(1, 0, 2, 3, 4).reshape(bsz, t, N_HEADS_F, HEAD_DIM)


def trunk(x, conv_state, past_k, past_v, past_logf, mem_k, mem_v,
          g_norm, w_in_a, conv_w, w_in_b, w_out, g_kv, w_kvf, b_f, g_final):
    bsz, t = x.shape[0], x.shape[1]
    past_len = past_k.shape[1]
    new_conv = []
    k_new = v_new = logf_new = None
    k_all = v_all = c_all = None
    for i in range(DEPTH):
        h = rmsnorm(x, g_norm[i])
        if i < N_A:
            proj = h @ w_in_a[i]
            b_g, c_g, u, z_c, q_m, z_m = jnp.split(
                proj, [CONV_DIM, 2 * CONV_DIM, 3 * CONV_DIM, 4 * CONV_DIM, 4 * CONV_DIM + M_DIM], axis=-1)
            conv_out, st = causal_depthwise_conv(c_g * u, conv_state[i], conv_w[i])
            new_conv.append(st)
            branch = b_g * conv_out * jax.nn.silu(z_c)
        else:
            if i == N_A:
                kvf = rmsnorm(x, g_kv) @ w_kvf
                k_flat, v_flat, f_logit = jnp.split(kvf, [F_DIM, 2 * F_DIM], axis=-1)
                k_new = k_flat.reshape(bsz, t, N_HEADS_F, HEAD_DIM)
                v_new = v_flat.reshape(bsz, t, N_HEADS_F, HEAD_DIM)
                logf_new = jax.nn.log_sigmoid(f_logit.astype(jnp.float32) + b_f.astype(jnp.float32))
                k_all = jnp.concatenate([past_k.astype(k_new.dtype), k_new], axis=1)
                v_all = jnp.concatenate([past_v.astype(v_new.dtype), v_new], axis=1)
                c_all = jnp.cumsum(jnp.concatenate([past_logf.astype(jnp.float32), logf_new], axis=1), axis=1)
            proj = h @ w_in_b[i - N_A]
            q_f, z_f, q_m, z_m = jnp.split(proj, [F_DIM, 2 * F_DIM, 2 * F_DIM + M_DIM], axis=-1)
            o = forgetting_attention(q_f.reshape(bsz, t, N_HEADS_F, HEAD_DIM), k_all, v_all, c_all, past_len)
            branch = o.reshape(bsz, t, F_DIM) * jax.nn.silu(z_f)
        o_m = memory_attention(q_m.reshape(bsz, t, N_HEADS_M, HEAD_DIM), mem_k[i], mem_v[i])
        mixed = jnp.concatenate([branch, o_m.reshape(bsz, t, M_DIM) * jax.nn.silu(z_m)], axis=-1)
        x = x + mixed @ w_out[i]
    y = rmsnorm(x, g_final)
    return y, jnp.stack(new_conv), k_new, v_new, logf_new


def setup_inputs(seed: int = 0) -> dict:
    key = jax.random.key(seed)
    ks = jax.random.split(key, 20)

    def nrm(k, shape, scale=1.0):
        return jax.random.normal(k, shape, jnp.float32) * scale

    return {
        'x_prompt': nrm(ks[0], (BATCH, SEQ, D_MODEL)),
        'x_sample': nrm(ks[1], (DEC_BATCH, DEC_SEQ, D_MODEL)),
        'state_conv': nrm(ks[2], (N_A, DEC_BATCH, CONV_W - 1, CONV_DIM)),
        'cache_k': nrm(ks[3], (DEC_BATCH, PAST_LEN, N_HEADS_F, HEAD_DIM)),
        'cache_v': nrm(ks[4], (DEC_BATCH, PAST_LEN, N_HEADS_F, HEAD_DIM)),
        'cache_logf': jax.nn.log_sigmoid(3.0 + nrm(ks[5], (DEC_BATCH, PAST_LEN, N_HEADS_F))),
        'cache_mem_k': nrm(ks[6], (DEPTH, DEC_BATCH, N_MEM, N_HEADS_M, HEAD_DIM)),
        'cache_mem_v': nrm(ks[7], (DEPTH, DEC_BATCH, N_MEM, N_HEADS_M, HEAD_DIM)),
        'mem_prompt': nrm(ks[8], (BATCH, N_MEM, D_MODEL)),
        'g_norm': 1.0 + 0.02 * nrm(ks[9], (DEPTH, D_MODEL)),
        'w_in_a': nrm(ks[10], (N_A, D_MODEL, IN_A), D_MODEL ** -0.5),
        'conv_w': nrm(ks[11], (N_A, CONV_W, CONV_DIM), CONV_W ** -0.5),
        'w_in_b': nrm(ks[12], (N_B, D_MODEL, IN_B), D_MODEL ** -0.5),
        'w_out': nrm(ks[13], (DEPTH, MIX_DIM, D_MODEL), MIX_DIM ** -0.5),
        'g_mem': 1.0 + 0.02 * nrm(ks[14], (DEPTH, D_MODEL)),
        'w_mem_kv': nrm(ks[15], (DEPTH, D_MODEL, 2 * M_DIM), D_MODEL ** -0.5),
        'g_kv': 1.0 + 0.02 * nrm(ks[16], (D_MODEL,)),
        'w_kvf': nrm(ks[17], (D_MODEL, KVF_DIM), D_MODEL ** -0.5),
        'b_f': 3.0 + 0.5 * nrm(ks[18], (N_HEADS_F,)),
        'g_final': 1.0 + 0.02 * nrm(ks[19], (D_MODEL,)),
    }


def reference(x_prompt, x_sample, state_conv, cache_k, cache_v, cache_logf, cache_mem_k, cache_mem_v,
              mem_prompt, g_norm, w_in_a, conv_w, w_in_b, w_out, g_mem, w_mem_kv, g_kv, w_kvf, b_f, g_final):
    pm = [memory_kv(mem_prompt, g_mem[i], w_mem_kv[i]) for i in range(DEPTH)]
    p_mem_k = jnp.stack([a for a, _ in pm])
    p_mem_v = jnp.stack([b for _, b in pm])
    bp = x_prompt.shape[0]
    dt = x_prompt.dtype
    zero_conv = jnp.zeros((N_A, bp, CONV_W - 1, CONV_DIM), dt)
    zero_kv = jnp.zeros((bp, 0, N_HEADS_F, HEAD_DIM), dt)
    zero_logf = jnp.zeros((bp, 0, N_HEADS_F), jnp.float32)
    y_prompt, p_state_conv, p_k, p_v, p_logf = trunk(
        x_prompt, zero_conv, zero_kv, zero_kv, zero_logf, p_mem_k, p_mem_v,
        g_norm, w_in_a, conv_w, w_in_b, w_out, g_kv, w_kvf, b_f, g_final)
    y_sample, s_state_conv, s_k, s_v, s_logf = trunk(
        x_sample, state_conv, cache_k, cache_v, cache_logf, cache_mem_k, cache_mem_v,
        g_norm, w_in_a, conv_w, w_in_b, w_out, g_kv, w_kvf, b_f, g_final)
    return (y_prompt, y_sample, p_state_conv, p_k, p_v, p_logf, p_mem_k, p_mem_v,
            s_state_conv, s_k, s_v, s_logf)
```

```cpp
#include <hip/hip_runtime.h>
#include <cstdio>
#include <cstdint>
#ifndef MK_N_LAUNCHES
#define MK_N_LAUNCHES 1
#endif
constexpr int DM = 2048, PB = 2, PT = 8192, SB = 16, ST = 64, PAST = 4096;
constexpr int MP = PB * PT, MS = SB * ST, MT = MP + MS;
constexpr int CD = 1536, NHF = 12, HD = 128, NMEM = 256, NHM = 4, MD = 512;
constexpr int INA = 7168, INB = 4096, KVF = 3084;
constexpr int SKV_S = PAST + ST;
constexpr float EPS = 1e-6f;
constexpr int NMB = PB + SB;
constexpr size_t OO_Y = 0;
constexpr size_t OO_PSTATE = OO_Y + (size_t)MT * DM;
constexpr size_t OO_PK = OO_PSTATE + (size_t)PB * 2 * CD;
constexpr size_t OO_PV = OO_PK + (size_t)MP * CD;
constexpr size_t OO_PLOGF = OO_PV + (size_t)MP * CD;
constexpr size_t OO_PMEMK = OO_PLOGF + (size_t)MP * NHF;
constexpr size_t OO_PMEMV = OO_PMEMK + (size_t)2 * PB * NMEM * MD;
constexpr size_t OO_SSTATE = OO_PMEMV + (size_t)2 * PB * NMEM * MD;
constexpr size_t OO_SK = OO_SSTATE + (size_t)SB * 2 * CD;
constexpr size_t OO_SV = OO_SK + (size_t)MS * CD;
constexpr size_t OO_SLOGF = OO_SV + (size_t)MS * CD;
constexpr size_t OUT_TOTAL = OO_SLOGF + (size_t)MS * NHF;
constexpr size_t MiB = 1u << 20;
constexpr size_t WS_CTL = 0, CTL_ZERO_BYTES = 1 * MiB;
constexpr size_t WS_WA = 2 * MiB;
constexpr size_t WS_WB = WS_WA + 36 * MiB;
constexpr size_t WS_WO = WS_WB + 28 * MiB;
constexpr size_t WS_WF = WS_WO + 16 * MiB;
constexpr size_t WS_XN = WS_WF + 1 * MiB;
constexpr size_t WS_X1 = WS_XN + 70 * MiB;
constexpr size_t WS_CU = WS_X1 + 136 * MiB;
constexpr size_t WS_BZ = WS_CU + 51 * MiB;
constexpr size_t WS_QM = WS_BZ + 51 * MiB;
constexpr size_t WS_SZM = WS_QM + 17 * MiB;
constexpr size_t WS_MIX = WS_SZM + 17 * MiB;
constexpr size_t WS_KB = WS_MIX + 68 * MiB;
constexpr size_t WS_VB = WS_KB + 48 * MiB;
constexpr size_t WS_QF = WS_VB + 48 * MiB;
constexpr size_t WS_SZF = WS_QF + 51 * MiB;
constexpr size_t WS_MEMK = WS_SZF + 51 * MiB;
constexpr size_t WS_MEMV = WS_MEMK + 9 * MiB;
constexpr size_t WS_KBIAS = WS_MEMV + 9 * MiB;
constexpr size_t KBIAS_S_OFF = (size_t)PB * NHF * PT;
constexpr size_t WS_END = WS_KBIAS + 4 * MiB;
static_assert(WS_END < (size_t)1536 * MiB, "d_ws map");
static_assert((size_t)(MT + 512) * DM * 2 <= 70 * MiB && (size_t)MT * CD * 2 <= 51 * MiB && (size_t)MT * DM * 4 <= 136 * MiB && (size_t)2 * NMB * NMEM * MD * 2 <= 9 * MiB, "d_ws map sizes");
static_assert((KBIAS_S_OFF + (size_t)SB * NHF * SKV_S) * 4 <= 4 * MiB, "kbias size");
constexpr int CW_TMO = 0, CW_CODE = 1;
constexpr int CW_BAR = 4096;
namespace pg8 {
#define PG8_LAS __attribute__((address_space(3)))
typedef unsigned short bf16_t;
typedef short bf16x8 __attribute__((ext_vector_type(8)));
typedef float f32x4 __attribute__((ext_vector_type(4)));
typedef unsigned u32x4 __attribute__((ext_vector_type(4)));
constexpr int BM = 256, BK = 64, HALF = 128, HTB = HALF * BK * 2  , STAGE_BYTES = 8 * HTB, NXCD = 8, WGM = 8;

__host__ __device__ __forceinline__ int lds_byte(int r, int c) { const int st = (r >> 4) * 2 + (c >> 5), rr = r & 15, cc = c & 31, ob = rr * 64 + cc * 2; return st * 1024 + (ob ^ (((ob >> 9) & 1) << 5)); }
__host__ __device__ __forceinline__ void stage_rc(int b, int& R, int& C) { const int st = b / 1024, sb = b % 1024, swz = sb ^ (((sb >> 9) & 1) << 5); R = (st >> 1) * 16 + swz / 64; C = (st & 1) * 32 + (swz % 64) / 2; }
__host__ __device__ __forceinline__ int perm32(int rho) { const int n = rho >> 4, i = rho & 15; return 8 * (i >> 2) + 4 * n + (i & 3); }

struct Unit { int pm, pn; };
struct Gemm { const bf16_t* A; const bf16_t* Bt; int M, N, K; };
__device__ __forceinline__ unsigned cvt_pk_bf16(float lo, float hi) { unsigned r; asm volatile("v_cvt_pk_bf16_f32 %0, %1, %2" : "=v"(r) : "v"(lo), "v"(hi)); return r; }
typedef float f32x2 __attribute__((ext_vector_type(2)));

struct GridOrder {
    int nM, nN, nwg, G, c, nEx, exPm0, exPn0, exNn;
    __device__ __forceinline__ void init(int nM_, int nN_, int G_, int c_, int nEx_ = 0, int exPm0_ = 0, int exPn0_ = 0, int exNn_ = 1) { nM = nM_; nN = nN_; nwg = nM * nN; G = G_; c = c_; nEx = nEx_; exPm0 = exPm0_; exPn0 = exPn0_; exNn = exNn_; }
    __device__ __forceinline__ bool next(int i, Unit& u) const {
        const long L = (long)i * G + c; if (L >= nwg + nEx) return false;
        if (L >= nwg) { const int e = (int)L - nwg; u.pm = exPm0 + e / exNn; u.pn = exPn0 + e % exNn; return true; }
        int wgid = (int)L; { const int q = nwg / NXCD, r = nwg % NXCD, xcd = wgid % NXCD, off = wgid / NXCD; wgid = (xcd < r ? xcd * (q + 1) : r * (q + 1) + (xcd - r) * q) + off; }
        const int nig = WGM * nN, gid = wgid / nig, fm = gid * WGM, gsz = (nM - fm) < WGM ? (nM - fm) : WGM;
        u.pm = fm + ((wgid % nig) % gsz); u.pn = (wgid % nig) / gsz; return true;
    }
    __device__ __forceinline__ void a_ready(const Unit&) const {}
    __device__ __forceinline__ void done(const Unit&) const {}
};

__device__ __forceinline__ float sigmoidf_(float z) { return __builtin_amdgcn_rcpf(1.0f + __builtin_amdgcn_exp2f(-1.4426950408889634f * z)); }
__device__ __forceinline__ f32x4 silu4(f32x4 z) { return (f32x4){z[0] * sigmoidf_(z[0]), z[1] * sigmoidf_(z[1]), z[2] * sigmoidf_(z[2]), z[3] * sigmoidf_(z[3])}; }
typedef unsigned u32x2 __attribute__((ext_vector_type(2)));
__device__ __forceinline__ u32x2 pk4(f32x4 v) { u32x2 w; w.x = cvt_pk_bf16(v[0], v[1]); w.y = cvt_pk_bf16(v[2], v[3]); return w; }
__device__ __forceinline__ u32x4 pk8(f32x4 a, f32x4 b) { u32x4 w; w.x = cvt_pk_bf16(a[0], a[1]); w.y = cvt_pk_bf16(a[2], a[3]); w.z = cvt_pk_bf16(b[0], b[1]); w.w = cvt_pk_bf16(b[2], b[3]); return w; }

struct EpiA {
    static constexpr bool PERM = false, AFTER_DRAIN = false;
    bf16_t *CUo, *BZo, *QMo, *SZMo, *MEMKo, *MEMVo; float* dout;
    __device__ __forceinline__ void operator()(const f32x4 (&acc)[2][2][4][2], const Unit& u, int wr, int wc, int fr, int fq) const {
        if (u.pn < 24) {
            const int ch0 = u.pn * 64 + wc * 16 + fq * 4;
#pragma unroll
            for (int ai = 0; ai < 2; ++ai)
#pragma unroll
                for (int m = 0; m < 4; ++m) {
                    const int rit = ai * HALF + wr * 64 + m * 16 + fr; const size_t row = (size_t)u.pm * BM + rit;
                    const f32x4 b = acc[ai][0][m][0], c = acc[ai][0][m][1], uu = acc[ai][1][m][0], z = acc[ai][1][m][1];
                    const f32x4 cu = c * uu, bz = b * silu4(z);
                    *(u32x2*)(CUo + row * CD + ch0) = pk4(cu); *(u32x2*)(BZo + row * CD + ch0) = pk4(bz);
                    if (u.pm < 64) { if ((u.pm & 31) == 31 && rit >= 254) *(f32x4*)(dout + OO_PSTATE + (size_t)((u.pm >> 5) * 2 + (rit - 254)) * CD + ch0) = cu; }
                    else { if ((rit & 63) >= 62) *(f32x4*)(dout + OO_SSTATE + (size_t)(((u.pm - 64) * 4 + (rit >> 6)) * 2 + ((rit & 63) - 62)) * CD + ch0) = cu; }
                }
        } else if (u.pn < 28) {
            const bool isz = u.pn >= 26; bf16_t* O = isz ? SZMo : QMo; const int col0 = ((u.pn - 24) & 1) * 256 + wc * 32 + fq * 8;
#pragma unroll
            for (int ai = 0; ai < 2; ++ai)
#pragma unroll
                for (int m = 0; m < 4; ++m) { bf16_t* rowp = O + ((size_t)u.pm * BM + ai * HALF + wr * 64 + m * 16 + fr) * MD + col0;
#pragma unroll
                    for (int bj = 0; bj < 2; ++bj) { f32x4 v0 = acc[ai][bj][m][0], v1 = acc[ai][bj][m][1]; if (isz) { v0 = silu4(v0); v1 = silu4(v1); }
                        *(u32x4*)(rowp + bj * HALF) = pk8(v0, v1); } }
        } else {
            const int e = u.pn - 28, layer = e >> 2, ct = e & 3, b = u.pm - 68; const bool isv = ct >= 2; const int col0 = (ct & 1) * 256 + wc * 32 + fq * 8;
            float* fo = dout + (isv ? OO_PMEMV : OO_PMEMK) + (size_t)(layer * PB + b) * NMEM * MD; bf16_t* ho = (isv ? MEMVo : MEMKo) + (size_t)(layer * NMB + b) * NMEM * MD;
#pragma unroll
            for (int ai = 0; ai < 2; ++ai)
#pragma unroll
                for (int m = 0; m < 4; ++m) { const size_t ro = (size_t)(ai * HALF + wr * 64 + m * 16 + fr) * MD + col0;
#pragma unroll
                    for (int bj = 0; bj < 2; ++bj) { const f32x4 v0 = acc[ai][bj][m][0], v1 = acc[ai][bj][m][1];
                        *(f32x4*)(fo + ro + bj * HALF) = v0; *(f32x4*)(fo + ro + bj * HALF + 4) = v1; *(u32x4*)(ho + ro + bj * HALF) = pk8(v0, v1); } }
        }
    }
};
struct EpiO {
    static constexpr bool PERM = false, AFTER_DRAIN = false;
    const float* base; const float* base2; float* out;
    __device__ __forceinline__ void operator()(const f32x4 (&acc)[2][2][4][2], const Unit& u, int wr, int wc, int fr, int fq) const {
        const float* bp = u.pm < 64 ? base : base2; const int col0 = u.pn * BM + wc * 32 + fq * 8;
#pragma unroll
        for (int ai = 0; ai < 2; ++ai)
#pragma unroll
            for (int m = 0; m < 4; ++m) { const size_t ro = ((size_t)u.pm * BM + ai * HALF + wr * 64 + m * 16 + fr) * DM + col0;
#pragma unroll
                for (int bj = 0; bj < 2; ++bj) { const f32x4 b0 = *(const f32x4*)(bp + ro + bj * HALF), b1 = *(const f32x4*)(bp + ro + bj * HALF + 4);
                    *(f32x4*)(out + ro + bj * HALF) = b0 + acc[ai][bj][m][0]; *(f32x4*)(out + ro + bj * HALF + 4) = b1 + acc[ai][bj][m][1]; }
                if (m & 1) asm volatile("" ::: "memory"); }
    }
};
struct EpiB {
    static constexpr bool PERM = false, AFTER_DRAIN = false;
    unsigned char* wsb; float* dout;
    __device__ __forceinline__ void operator()(const f32x4 (&acc)[2][2][4][2], const Unit& u, int wr, int wc, int fr, int fq) const {
        const int cin = wc * 32 + fq * 8;
        if (u.pn < 12) {
            const bool isv = u.pn >= 6; const int col0 = (u.pn - (isv ? 6 : 0)) * BM + cin; const bool pr = u.pm < 64;
            float* fo = pr ? dout + (isv ? OO_PV : OO_PK) : dout + (isv ? OO_SV : OO_SK) - (size_t)MP * CD; bf16_t* ho = (bf16_t*)(wsb + (isv ? WS_VB : WS_KB));
#pragma unroll
            for (int ai = 0; ai < 2; ++ai)
#pragma unroll
                for (int m = 0; m < 4; ++m) { const size_t ro = ((size_t)u.pm * BM + ai * HALF + wr * 64 + m * 16 + fr) * CD + col0;
#pragma unroll
                    for (int bj = 0; bj < 2; ++bj) { const f32x4 v0 = acc[ai][bj][m][0], v1 = acc[ai][bj][m][1];
                        *(f32x4*)(fo + ro + bj * HALF) = v0; *(f32x4*)(fo + ro + bj * HALF + 4) = v1; if (pr) *(u32x4*)(ho + ro + bj * HALF) = pk8(v0, v1); } }
        } else {
            size_t ob; int ld, col0; bool act;
            if (u.pn < 18) { ob = WS_QF; ld = CD; col0 = (u.pn - 12) * BM; act = false; } else if (u.pn < 24) { ob = WS_SZF; ld = CD; col0 = (u.pn - 18) * BM; act = true; }
            else if (u.pn < 26) { ob = WS_QM; ld = MD; col0 = (u.pn - 24) * BM; act = false; } else { ob = WS_SZM; ld = MD; col0 = (u.pn - 26) * BM; act = true; }
            bf16_t* O = (bf16_t*)(wsb + ob); col0 += cin;
#pragma unroll
            for (int ai = 0; ai < 2; ++ai)
#pragma unroll
                for (int m = 0; m < 4; ++m) { bf16_t* rowp = O + ((size_t)u.pm * BM + ai * HALF + wr * 64 + m * 16 + fr) * ld + col0;
#pragma unroll
                    for (int bj = 0; bj < 2; ++bj) { f32x4 v0 = acc[ai][bj][m][0], v1 = acc[ai][bj][m][1]; if (act) { v0 = silu4(v0); v1 = silu4(v1); }
                        *(u32x4*)(rowp + bj * HALF) = pk8(v0, v1); } }
        }
    }
};
template <class Epi, class Sched, bool ALIGN_EPI = false, bool SP2 = false>
__device__ __forceinline__ void gemm_phase(PG8_LAS unsigned char* lds, const Gemm g, const Sched& S, const Epi& E) {
    int tid_ = threadIdx.x; asm volatile("" : "+v"(tid_));
    const int tid = tid_, wid = __builtin_amdgcn_readfirstlane(tid >> 6), lane = tid & 63, wr = wid >> 2, wc = wid & 3, fr = lane & 15, fq = lane >> 4;
    const int K = g.K, nt = K / BK;
    unsigned voffA[2], voffB[2];
#pragma unroll
    for (int i = 0; i < 2; ++i) { int R, C; stage_rc(tid * 16 + i * 8192, R, C); const int Rb = Epi::PERM ? ((R & ~31) + perm32(R & 31)) : R;
        voffA[i] = (unsigned)(R * K + C) * 2u; voffB[i] = (unsigned)(Rb * K + C) * 2u; }
    const size_t kstep = (size_t)(BK * 2);
    const size_t hstep = (size_t)HALF * K * 2;
    const size_t tstep = 2 * hstep;
    const unsigned ldsw = (unsigned)wid * 1024u;
    const int aoff = lds_byte(wr * 64 + fr, fq * 8), boff = lds_byte(wc * 32 + fr, fq * 8);
#define PG8_SA(b, h) (((b) * 2 + (h)) * HTB)
#define PG8_SB(b, h) ((4 + (b) * 2 + (h)) * HTB)
#define PG8_STAGE(bufoff, gbase, voff) do { _Pragma("unroll") for (int _i = 0; _i < 2; ++_i) \
        __builtin_amdgcn_global_load_lds((const unsigned*)((const char*)(gbase) + (voff)[_i]), (PG8_LAS unsigned*)(lds + (bufoff) + ldsw + _i * 8192), 16, 0, 0); } while (0)
#define PG8_LDA(dst, b, h) do { _Pragma("unroll") for (int m = 0; m < 4; ++m) _Pragma("unroll") for (int k = 0; k < 2; ++k) dst[m][k] = *(const PG8_LAS bf16x8*)(lds + PG8_SA(b, h) + aoff + m * 2048 + k * 1024); } while (0)
#define PG8_LDB(dst, b, h) do { _Pragma("unroll") for (int n = 0; n < 2; ++n) _Pragma("unroll") for (int k = 0; k < 2; ++k) dst[n][k] = *(const PG8_LAS bf16x8*)(lds + PG8_SB(b, h) + boff + n * 2048 + k * 1024); } while (0)
#define PG8_MMA(ai, bj, At, Bt) do { __builtin_amdgcn_s_setprio(1); _Pragma("unroll") for (int m = 0; m < 4; ++m) _Pragma("unroll") for (int n = 0; n < 2; ++n) _Pragma("unroll") for (int k = 0; k < 2; ++k) \
        acc[ai][bj][m][n] = __builtin_amdgcn_mfma_f32_16x16x32_bf16(Bt[n][k], At[m][k], acc[ai][bj][m][n], 0, 0, 0); __builtin_amdgcn_s_setprio(0); } while (0)
#define PG8_WAIT_V(n) asm volatile("s_waitcnt vmcnt(" #n ")" ::: "memory")
#define PG8_WAIT_L(n) asm volatile("s_waitcnt lgkmcnt(" #n ")" ::: "memory")
#define PG8_BAR __builtin_amdgcn_s_barrier()
#define PG8_SCHED __builtin_amdgcn_sched_barrier(0)
    Unit cur, nxt; int ui = 0;
    if (!S.next(0, cur)) return;
    f32x4 acc[2][2][4][2];
#pragma unroll
    for (int a = 0; a < 2; ++a)
#pragma unroll
        for (int b = 0; b < 2; ++b)
#pragma unroll
            for (int m = 0; m < 4; ++m)
#pragma unroll
                for (int n = 0; n < 2; ++n) acc[a][b][m][n] = (f32x4){0.f, 0.f, 0.f, 0.f};
    bf16x8 At[4][2], B0[2][2], B1[2][2];
    const char* cA = (const char*)g.A + (size_t)cur.pm * tstep; const char* cB = (const char*)g.Bt + (size_t)cur.pn * tstep;
    S.a_ready(cur);
    if constexpr (SP2) {
        PG8_STAGE(PG8_SB(0, 0), cB, voffB); PG8_STAGE(PG8_SB(0, 1), cB + hstep, voffB); PG8_STAGE(PG8_SA(0, 0), cA, voffA); PG8_STAGE(PG8_SA(0, 1), cA + hstep, voffA);
        if (wr == 1) PG8_BAR;
        PG8_WAIT_V(2); PG8_BAR;
        PG8_STAGE(PG8_SB(1, 0), cB + kstep, voffB); PG8_STAGE(PG8_SA(1, 0), cA + kstep, voffA); PG8_STAGE(PG8_SB(1, 1), cB + hstep + kstep, voffB);
        PG8_WAIT_V(6); PG8_BAR;
    } else {
        PG8_STAGE(PG8_SB(0, 0), cB, voffB); PG8_STAGE(PG8_SA(0, 0), cA, voffA); PG8_STAGE(PG8_SB(0, 1), cB + hstep, voffB); PG8_STAGE(PG8_SA(0, 1), cA + hstep, voffA);
        if (wr == 1) PG8_BAR;
        PG8_WAIT_V(4); PG8_BAR;
        PG8_STAGE(PG8_SB(1, 0), cB + kstep, voffB); PG8_STAGE(PG8_SA(1, 0), cA + kstep, voffA); PG8_STAGE(PG8_SB(1, 1), cB + hstep + kstep, voffB);
        PG8_WAIT_V(6); PG8_BAR;
    }
    for (;;) {
        const bool has_next = S.next(ui + 1, nxt);
        const char* nA = has_next ? (const char*)g.A + (size_t)nxt.pm * tstep : cA; const char* nB = has_next ? (const char*)g.Bt + (size_t)nxt.pn * tstep : cB;
        for (int t = 0; t < nt; t += 2) {
            const bool last = (t == nt - 2);
            const char* a1 = cA + (size_t)(t + 1) * kstep;
            const char* a2 = last ? nA : cA + (size_t)(t + 2) * kstep; const char* b2 = last ? nB : cB + (size_t)(t + 2) * kstep;
            const char* a3 = a2 + kstep; const char* b3 = b2 + kstep;
            if (last && has_next) S.a_ready(nxt);
            if constexpr (SP2) {
            PG8_LDB(B0, 0, 0); PG8_LDB(B1, 0, 1); PG8_SCHED; PG8_LDA(At, 0, 0); PG8_STAGE(PG8_SA(1, 1), a1 + hstep, voffA);
            PG8_WAIT_V(8); PG8_WAIT_L(0); PG8_BAR; PG8_MMA(0, 0, At, B0); PG8_MMA(0, 1, At, B1); PG8_BAR; PG8_SCHED;
            PG8_LDA(At, 0, 1); PG8_STAGE(PG8_SB(0, 0), b2, voffB); PG8_STAGE(PG8_SB(0, 1), b2 + hstep, voffB); PG8_STAGE(PG8_SA(0, 0), a2, voffA);
            PG8_WAIT_V(8); PG8_WAIT_L(0); PG8_BAR; PG8_MMA(1, 0, At, B0); PG8_MMA(1, 1, At, B1); PG8_BAR; PG8_SCHED;
            PG8_LDB(B0, 1, 0); PG8_LDB(B1, 1, 1); PG8_SCHED; PG8_LDA(At, 1, 0); PG8_STAGE(PG8_SA(0, 1), a2 + hstep, voffA);
            PG8_WAIT_V(8); PG8_WAIT_L(0); PG8_BAR; PG8_MMA(0, 0, At, B0); PG8_MMA(0, 1, At, B1); PG8_BAR; PG8_SCHED;
            PG8_LDA(At, 1, 1); PG8_STAGE(PG8_SB(1, 0), b3, voffB); PG8_STAGE(PG8_SB(1, 1), b3 + hstep, voffB); PG8_STAGE(PG8_SA(1, 0), a3, voffA);
            PG8_WAIT_V(8); PG8_WAIT_L(0); PG8_BAR; PG8_MMA(1, 0, At, B0); PG8_MMA(1, 1, At, B1); PG8_BAR; PG8_SCHED;
            } else {
            PG8_LDB(B0, 0, 0); PG8_SCHED; PG8_LDA(At, 0, 0); PG8_STAGE(PG8_SA(1, 1), a1 + hstep, voffA);
            PG8_WAIT_L(8); PG8_BAR; PG8_WAIT_L(0); PG8_MMA(0, 0, At, B0); PG8_BAR; PG8_SCHED;
            PG8_LDB(B1, 0, 1); PG8_STAGE(PG8_SB(0, 0), b2, voffB);
            PG8_BAR; PG8_WAIT_L(0); PG8_MMA(0, 1, At, B1); PG8_BAR;
            PG8_LDA(At, 0, 1); PG8_STAGE(PG8_SA(0, 0), a2, voffA);
            PG8_BAR; PG8_WAIT_L(0); PG8_MMA(1, 0, At, B0); PG8_BAR; PG8_SCHED;
            PG8_STAGE(PG8_SB(0, 1), b2 + hstep, voffB);
            PG8_WAIT_V(6); PG8_BAR; PG8_MMA(1, 1, At, B1); PG8_BAR;
            PG8_LDB(B0, 1, 0); PG8_SCHED; PG8_LDA(At, 1, 0); PG8_STAGE(PG8_SA(0, 1), a2 + hstep, voffA);
            PG8_WAIT_L(8); PG8_BAR; PG8_WAIT_L(0); PG8_MMA(0, 0, At, B0); PG8_BAR; PG8_SCHED;
            PG8_LDB(B1, 1, 1); PG8_STAGE(PG8_SB(1, 0), b3, voffB);
            PG8_BAR; PG8_WAIT_L(0); PG8_MMA(0, 1, At, B1); PG8_BAR;
            PG8_LDA(At, 1, 1); PG8_STAGE(PG8_SA(1, 0), a3, voffA);
            PG8_BAR; PG8_WAIT_L(0); PG8_MMA(1, 0, At, B0); PG8_BAR; PG8_SCHED;
            PG8_STAGE(PG8_SB(1, 1), b3 + hstep, voffB);
            PG8_WAIT_V(6); PG8_BAR; PG8_MMA(1, 1, At, B1); PG8_BAR;
            }
        }
        if constexpr (ALIGN_EPI) { if (wr == 0) PG8_BAR; }
        if constexpr (!Epi::AFTER_DRAIN) { E(acc, cur, wr, wc, fr, fq); S.done(cur); }
        if (!has_next) break;
#pragma unroll
        for (int a = 0; a < 2; ++a)
#pragma unroll
            for (int b = 0; b < 2; ++b)
#pragma unroll
                for (int m = 0; m < 4; ++m)
#pragma unroll
                    for (int n = 0; n < 2; ++n) acc[a][b][m][n] = (f32x4){0.f, 0.f, 0.f, 0.f};
        cur = nxt; cA = nA; cB = nB; ++ui;
        if constexpr (ALIGN_EPI) { if (wr == 1) PG8_BAR; }
    }
    PG8_WAIT_V(0);
    if constexpr (!ALIGN_EPI) { if (wr == 0) PG8_BAR; }
    PG8_BAR;
    if constexpr (Epi::AFTER_DRAIN) { E.fused(acc, cur, wr, wc, fr, fq, lds, wid, lane); S.done(cur); }
#undef PG8_SA
#undef PG8_SB
#undef PG8_STAGE
#undef PG8_LDA
#undef PG8_LDB
#undef PG8_MMA
#undef PG8_WAIT_V
#undef PG8_WAIT_L
#undef PG8_BAR
#undef PG8_SCHED
}
}
namespace fa {
typedef unsigned short bf16_t;
typedef short bf16x8 __attribute__((ext_vector_type(8)));
typedef short s16x4 __attribute__((ext_vector_type(4)));
typedef float f32x16 __attribute__((ext_vector_type(16)));
typedef float f32x4 __attribute__((ext_vector_type(4)));
typedef unsigned u32x4 __attribute__((ext_vector_type(4)));
template <class A, class Bt> struct same_t { static constexpr bool v = false; };
template <class A> struct same_t<A, A> { static constexpr bool v = true; };
constexpr float SCALE = 0.08838834764831845f;
constexpr float THR = 8.f;
constexpr int D = 128, NW = 8, QBLK = 32, KVBLK = 64, QB = NW * QBLK;
constexpr int SHM_V = KVBLK * D * 2, SHM_K = KVBLK * D * 2;
constexpr int LDS_WS = 2 * SHM_V + 2 * SHM_K;
constexpr int LDS_BIAS = LDS_WS + NW * 64 * 4;
constexpr int BIAS_KEYS = 8192;
constexpr int LDS_BYTES = LDS_BIAS + BIAS_KEYS * 4;
constexpr unsigned WINF = 0x40000000u;

#define KSWZ(row, colB) ((row) * 256 + ((colB) ^ (((row) & 7) << 4)))
#define SBAR() __builtin_amdgcn_sched_barrier(0)
__device__ __forceinline__ int v_st(int k, int c) { const int kk = (k & ~0xC) | ((k & 4) << 1) | ((k & 8) >> 1); return ((kk >> 3) * 4 + (c >> 5)) * 512 + ((kk & 7) * 32 + (c & 31)) * 2; }
__device__ __forceinline__ int v_rd_base(int lane) { return ((lane & 3) << 3) | (((lane >> 2) & 3) << 6) | (((lane >> 4) & 1) << 5) | (((lane >> 5) & 1) << 8); }
constexpr int v_rd_off(int d0, int ks, int half) { return d0 * 512 + ks * 4096 + half * 2048; }
__device__ __forceinline__ int crow(int r, int hi) { return (r & 3) + 8 * (r >> 2) + 4 * hi; }
__device__ __forceinline__ unsigned cvtpk(float lo, float hi) { unsigned r; asm volatile("v_cvt_pk_bf16_f32 %0, %1, %2" : "=v"(r) : "v"(lo), "v"(hi)); return r; }
__device__ __forceinline__ bf16x8 pack8(f32x4 a, f32x4 b) { u32x4 w = {cvtpk(a[0], a[1]), cvtpk(a[2], a[3]), cvtpk(b[0], b[1]), cvtpk(b[2], b[3])}; return *reinterpret_cast<bf16x8*>(&w); }
__device__ __forceinline__ bf16x8 ld8h(const bf16_t* p) { return *reinterpret_cast<const bf16x8*>(p); }
__device__ __forceinline__ void mask_tile(f32x16& p0, f32x16& p1, int dq, unsigned W) {
    const float NEG = -__builtin_inff();
#pragma unroll
    for (int r = 0; r < 16; ++r) { const int c = (r & 3) + 8 * (r >> 2);
        if ((unsigned)(dq - c) >= W) p0[r] = NEG;
        if ((unsigned)(dq - c - 32) >= W) p1[r] = NEG; }
}
__device__ __forceinline__ void partialSM(f32x16& p0, f32x16& p1, float& m_reg, float& mn, float& alpha) {
    float pmax = p0[0]; for (int r = 1; r < 16; ++r) pmax = fmaxf(pmax, p0[r]); for (int r = 0; r < 16; ++r) pmax = fmaxf(pmax, p1[r]);
    { auto rr = __builtin_amdgcn_permlane32_swap(__float_as_uint(pmax), __float_as_uint(pmax), false, false);
      pmax = fmaxf(__uint_as_float(rr[0]), __uint_as_float(rr[1])); }
    constexpr float C2 = 1.4426950408889634f * SCALE;
    if (__builtin_expect(__all((pmax - m_reg) * SCALE <= THR), 1)) { mn = m_reg; alpha = 1.f; }
    else { mn = fmaxf(m_reg, pmax); alpha = __builtin_amdgcn_exp2f((m_reg - mn) * C2); m_reg = mn; }
    const float mnL = -mn * C2;
    for (int r = 0; r < 16; ++r) p0[r] = fmaf(p0[r], C2, mnL); for (int r = 0; r < 16; ++r) p1[r] = fmaf(p1[r], C2, mnL);
    for (int r = 0; r < 16; ++r) p0[r] = __builtin_amdgcn_exp2f(p0[r]);
}
__device__ __forceinline__ void finishSM(f32x16& p0, f32x16& p1, float alpha, float& l_reg, bf16x8& pa0, bf16x8& pa1, bf16x8& pa2, bf16x8& pa3) {
    for (int r = 0; r < 16; ++r) p1[r] = __builtin_amdgcn_exp2f(p1[r]);
    float ps = 0; for (int r = 0; r < 16; ++r) ps += p0[r]; for (int r = 0; r < 16; ++r) ps += p1[r];
    { auto rr = __builtin_amdgcn_permlane32_swap(__float_as_uint(ps), __float_as_uint(ps), false, false);
      ps = __uint_as_float(rr[0]) + __uint_as_float(rr[1]); }
    l_reg = l_reg * alpha + ps;
#define PK4(P, B_, OUT) do { unsigned a0 = cvtpk(P[B_+0], P[B_+1]), a1 = cvtpk(P[B_+2], P[B_+3]);                          \
        unsigned b0 = cvtpk(P[B_+4], P[B_+5]), b1 = cvtpk(P[B_+6], P[B_+7]);                                             \
        auto r0 = __builtin_amdgcn_permlane32_swap(a0, b0, false, false); auto r1 = __builtin_amdgcn_permlane32_swap(a1, b1, false, false); \
        u32x4 w = {r0[0], r1[0], r0[1], r1[1]}; OUT = *reinterpret_cast<bf16x8*>(&w); } while (0)
    PK4(p0, 0, pa0); PK4(p0, 8, pa1); PK4(p1, 0, pa2); PK4(p1, 8, pa3);
#undef PK4
}
template <int KB>
__device__ __forceinline__ void qkt(f32x16& p0, f32x16& p1, const char* K_lds, const char* bl, int r32, int hi, const bf16x8* qr) {
#pragma unroll
    for (int j = 0; j < 4; ++j) { const f32x4 a = *reinterpret_cast<const f32x4*>(bl + 32 * j), b = *reinterpret_cast<const f32x4*>(bl + 128 + 32 * j);
        p0[4 * j] = a[0]; p0[4 * j + 1] = a[1]; p0[4 * j + 2] = a[2]; p0[4 * j + 3] = a[3]; p1[4 * j] = b[0]; p1[4 * j + 1] = b[1]; p1[4 * j + 2] = b[2]; p1[4 * j + 3] = b[3]; }
    const char* kb[4];
#pragma unroll
    for (int dd = 0; dd < 4; ++dd) kb[dd] = K_lds + KB * SHM_K + KSWZ(r32, (dd * 16 + hi * 8) * 2);
#pragma unroll
    for (int d0 = 0; d0 < 8; ++d0) { const char* a = kb[d0 & 3] + (d0 >> 2) * 128;
        bf16x8 b0 = *reinterpret_cast<const bf16x8*>(a);
        bf16x8 b1 = *reinterpret_cast<const bf16x8*>(a + 32 * 256);
        p0 = __builtin_amdgcn_mfma_f32_32x32x16_bf16(b0, qr[d0], p0, 0, 0, 0);
        p1 = __builtin_amdgcn_mfma_f32_32x32x16_bf16(b1, qr[d0], p1, 0, 0, 0); }
}
template <int VB>
__device__ __forceinline__ void pv_tile(f32x16* o, int vb0, bf16x8 pa0, bf16x8 pa1, bf16x8 pa2, bf16x8 pa3) {
#define TRRD(dst, off) asm volatile("ds_read_b64_tr_b16 %0, %1 offset:%2" : "=&v"(dst) : "v"(vb0), "i"(off) : "memory")
#define PV_D0(d0) do { s16x4 l0, l1, l2, l3, h0, h1, h2, h3; constexpr int b_ = VB * SHM_V + v_rd_off(d0, 0, 0);     \
        TRRD(l0, b_); TRRD(h0, b_ + 2048); TRRD(l1, b_ + 4096); TRRD(h1, b_ + 6144); TRRD(l2, b_ + 8192); TRRD(h2, b_ + 10240); TRRD(l3, b_ + 12288); TRRD(h3, b_ + 14336); \
        asm volatile("s_waitcnt lgkmcnt(0)" ::: "memory"); SBAR();                 \
        o[d0] = __builtin_amdgcn_mfma_f32_32x32x16_bf16(pa0, (bf16x8){l0[0], l0[1], l0[2], l0[3], h0[0], h0[1], h0[2], h0[3]}, o[d0], 0, 0, 0);   \
        o[d0] = __builtin_amdgcn_mfma_f32_32x32x16_bf16(pa1, (bf16x8){l1[0], l1[1], l1[2], l1[3], h1[0], h1[1], h1[2], h1[3]}, o[d0], 0, 0, 0);   \
        o[d0] = __builtin_amdgcn_mfma_f32_32x32x16_bf16(pa2, (bf16x8){l2[0], l2[1], l2[2], l2[3], h2[0], h2[1], h2[2], h2[3]}, o[d0], 0, 0, 0);   \
        o[d0] = __builtin_amdgcn_mfma_f32_32x32x16_bf16(pa3, (bf16x8){l3[0], l3[1], l3[2], l3[3], h3[0], h3[1], h3[2], h3[3]}, o[d0], 0, 0, 0); } while (0)
    PV_D0(0); PV_D0(1); PV_D0(2); PV_D0(3);
#undef PV_D0
#undef TRRD
}

template <class TKV> struct BlockRef { const bf16_t* Q; const TKV* K; const TKV* V; const TKV* K2; const TKV* V2; bf16_t* O; const bf16_t* G; const float* bias; int P0, skv, nvalid; };
struct Geom { int ldq, ldk, ldo, ldg, ksplit; };
template <class TKV> struct Seam { bf16x8 qr[8]; bf16x8 st_v0, st_v1, st_k0, st_k1; f32x4 sf0, sf1, sf2, sf3; };

#define ROW(p, k0, rr) ((p) + (size_t)((k0) + (rr)) * g.ldk + sc)
#define KSEL(B_, k0) (((k0) >= g.ksplit) ? (B_).K2 : (B_).K)
#define VSEL(B_, k0) (((k0) >= g.ksplit) ? (B_).V2 : (B_).V)
#define VMW() asm volatile("s_waitcnt vmcnt(0)" ::: "memory")
#define VMWN(n) asm volatile("s_waitcnt vmcnt(%0)" :: "i"(n) : "memory")
#define SLOAD_H(Kp, Vp, k0) do { S.st_v0 = ld8h((const bf16_t*)ROW(Vp, k0, sr)); S.st_v1 = ld8h((const bf16_t*)ROW(Vp, k0, 32 + sr));              \
                         S.st_k0 = ld8h((const bf16_t*)ROW(Kp, k0, sr)); S.st_k1 = ld8h((const bf16_t*)ROW(Kp, k0, 32 + sr)); } while (0)
#define SWRITE_HK(bf) do { *(bf16x8*)(K_lds + (bf) * SHM_K + kws) = S.st_k0; *(bf16x8*)(K_lds + (bf) * SHM_K + kws + 32 * 256) = S.st_k1; } while (0)
#define SWRITE_HV(bf) do { *(bf16x8*)(V_lds + (bf) * SHM_V + vst0) = S.st_v0; *(bf16x8*)(V_lds + (bf) * SHM_V + vst1) = S.st_v1; } while (0)
#define SWRITE_H(bf) do { SWRITE_HV(bf); SWRITE_HK(bf); } while (0)
#define SLOAD_F(p, k0) do { S.sf0 = *(const f32x4*)ROW(p, k0, sr); S.sf1 = *(const f32x4*)(ROW(p, k0, sr) + 4);                \
                            S.sf2 = *(const f32x4*)ROW(p, k0, 32 + sr); S.sf3 = *(const f32x4*)(ROW(p, k0, 32 + sr) + 4); } while (0)
#define SWRITE_KF(bf) do { *(bf16x8*)(K_lds + (bf) * SHM_K + kws) = pack8(S.sf0, S.sf1); *(bf16x8*)(K_lds + (bf) * SHM_K + kws + 32 * 256) = pack8(S.sf2, S.sf3); } while (0)
#define SWRITE_VF(bf) do { *(bf16x8*)(V_lds + (bf) * SHM_V + vst0) = pack8(S.sf0, S.sf1); *(bf16x8*)(V_lds + (bf) * SHM_V + vst1) = pack8(S.sf2, S.sf3); } while (0)
#define QROWP(B_) ((B_).Q + (size_t)((wid * QBLK + r32) & ((B_).nvalid - 1)) * g.ldq + hi * 8)
template <class TKV>
__device__ __forceinline__ void attn_prime(const BlockRef<TKV>& cur, const Geom g, char* lds, Seam<TKV>& S) {
    constexpr bool F32 = same_t<TKV, float>::v;
    int tid_ = threadIdx.x; asm volatile("" : "+v"(tid_));
    const int tid = tid_, wid = __builtin_amdgcn_readfirstlane(tid >> 6), lane = tid & 63, r32 = lane & 31, hi = lane >> 5;
    const int sr = tid >> 4, sc = (tid & 15) * 8, kws = KSWZ(sr, sc * 2); char* K_lds = lds + 2 * SHM_V;
    { const bf16_t* qp = QROWP(cur);
#pragma unroll
      for (int d0 = 0; d0 < 8; ++d0) S.qr[d0] = ld8h(qp + d0 * 16); }
    if constexpr (F32) { SLOAD_F((const float*)KSEL(cur, 0), 0); VMW(); SWRITE_KF(0); SBAR(); SLOAD_F((const float*)VSEL(cur, 0), 0); }
    else { SLOAD_H(KSEL(cur, 0), VSEL(cur, 0), 0); VMW(); SWRITE_HK(0); }
    __syncthreads();
}
template <class TKV>
__device__ __forceinline__ void attn_block(const BlockRef<TKV>& cur, const BlockRef<TKV>& nxt, const Geom g, char* lds, Seam<TKV>& S) {
    constexpr bool F32 = same_t<TKV, float>::v;
    int tid_ = threadIdx.x; asm volatile("" : "+v"(tid_));
    const int tid = tid_, wid = __builtin_amdgcn_readfirstlane(tid >> 6), lane = tid & 63, r32 = lane & 31, hi = lane >> 5;
    int j_hi = (cur.P0 + QB - 1) / KVBLK + 1; if (j_hi > cur.skv / KVBLK) j_hi = cur.skv / KVBLK;
    const int NT = j_hi;
    const int qlo = cur.P0 + wid * QBLK, qm = qlo + r32 - 4 * hi;
    char* V_lds = lds; char* K_lds = lds + 2 * SHM_V;
    float* ws = (float*)(lds + LDS_WS) + wid * 64; float* li_l = ws, * al_l = ws + 32;
    const char* bl = lds + LDS_BIAS + hi * 16;
    float m_reg = -1e30f, l_reg = 0; f32x16 o[4] = {};
    const int sr = tid >> 4, sc = (tid & 15) * 8, vst0 = v_st(sr, sc), vst1 = v_st(32 + sr, sc), kws = KSWZ(sr, sc * 2);
    const int vb0 = (int)(uintptr_t)V_lds + v_rd_base(lane);
    if (cur.bias) { const f32x4* bsrc = (const f32x4*)cur.bias; f32x4* bdst = (f32x4*)(lds + LDS_BIAS);
        for (int i = tid; i < NT * 16; i += NW * 64) bdst[i] = bsrc[i];
        __syncthreads(); }
#define RESC(a) do { if (__any((a) < 1.f)) { if (hi == 0) al_l[r32] = (a); asm volatile("s_waitcnt lgkmcnt(0)" ::: "memory");              \
                     for (int d_ = 0; d_ < 4; ++d_) for (int r = 0; r < 16; ++r) o[d_][r] *= al_l[crow(r, hi)]; } } while (0)
#define KBASE(t) ((t) * KVBLK)
#define MASKT(P0_, P1_, t) do { const int kb_ = KBASE(t); if (kb_ + KVBLK - 1 > qlo) mask_tile(P0_, P1_, qm - kb_, WINF); } while (0)
    constexpr int NQL = 8;
#define SEAM_K0() do { VMWN(NQL); if constexpr (F32) { SWRITE_KF(0); SBAR(); SLOAD_F((const float*)VSEL(nxt, 0), 0); } else { SWRITE_HK(0); } SBAR(); } while (0)
    f32x16 pA0, pA1, pB0, pB1; float mnA, mnB, alA, alB; bf16x8 pa0, pa1, pa2, pa3;
    if constexpr (F32) { VMW(); SWRITE_VF(0); SBAR(); } else { SWRITE_HV(0); SBAR(); }
    if (NT > 1) { if constexpr (F32) SLOAD_F((const float*)KSEL(cur, KBASE(1)), KBASE(1)); else SLOAD_H(KSEL(cur, KBASE(1)), VSEL(cur, KBASE(1)), KBASE(1)); }
    SBAR(); qkt<0>(pA0, pA1, K_lds, bl + KBASE(0) * 4, r32, hi, S.qr);
    if constexpr (F32) { if (NT > 1) { VMW(); SWRITE_KF(1); SBAR(); SLOAD_F((const float*)VSEL(cur, KBASE(1)), KBASE(1)); } }
    MASKT(pA0, pA1, 0); partialSM(pA0, pA1, m_reg, mnA, alA);
    if (NT > 1) { VMW(); if constexpr (F32) { SWRITE_VF(1); SBAR(); if (NT > 2) SLOAD_F((const float*)KSEL(cur, KBASE(2)), KBASE(2)); } else SWRITE_H(1); }
    __syncthreads();
#define HALF_STEP(PX0, PX1, mnX, alX, PY0, PY1, alY, t, KB, VB, SB) do {                                                      \
        SBAR(); qkt<KB>(PX0, PX1, K_lds, bl + KBASE(t) * 4, r32, hi, S.qr);                                                   \
        finishSM(PY0, PY1, alY, l_reg, pa0, pa1, pa2, pa3); SBAR();                                                           \
        if ((t) + 1 < NT) { if constexpr (F32) { VMW(); SWRITE_KF(SB); SBAR(); SLOAD_F((const float*)VSEL(cur, KBASE((t) + 1)), KBASE((t) + 1)); }  \
                            else { SLOAD_H(KSEL(cur, KBASE((t) + 1)), VSEL(cur, KBASE((t) + 1)), KBASE((t) + 1)); } SBAR(); }          \
        pv_tile<VB>(o, vb0, pa0, pa1, pa2, pa3); MASKT(PX0, PX1, (t)); partialSM(PX0, PX1, m_reg, mnX, alX);                   \
        __syncthreads();                                                                                                      \
        if ((t) + 1 < NT) { VMW(); if constexpr (F32) { SWRITE_VF(SB); SBAR(); if ((t) + 2 < NT) SLOAD_F((const float*)KSEL(cur, KBASE((t) + 2)), KBASE((t) + 2)); } \
                            else { SWRITE_H(SB); } }                                                                          \
        RESC(alX); __syncthreads(); } while (0)
    for (int t = 1; t + 1 < NT; t += 2) {
        HALF_STEP(pB0, pB1, mnB, alB, pA0, pA1, alA, t, 1, 0, 0);
        HALF_STEP(pA0, pA1, mnA, alA, pB0, pB1, alB, t + 1, 0, 1, 1);
    }
    const bool even = (NT & 1) == 0;
    if (even) { SBAR(); qkt<1>(pB0, pB1, K_lds, bl + KBASE(NT - 1) * 4, r32, hi, S.qr); SBAR(); }
    if constexpr (F32) { SLOAD_F((const float*)KSEL(nxt, 0), 0); SBAR(); } else { SLOAD_H(KSEL(nxt, 0), VSEL(nxt, 0), 0); SBAR(); }
    { const bf16_t* qp = QROWP(nxt);
#pragma unroll
      for (int d0 = 0; d0 < 8; ++d0) S.qr[d0] = ld8h(qp + d0 * 16); }
    SBAR();
    finishSM(pA0, pA1, alA, l_reg, pa0, pa1, pa2, pa3); SBAR();
    pv_tile<0>(o, vb0, pa0, pa1, pa2, pa3);
    if (even) { MASKT(pB0, pB1, NT - 1); partialSM(pB0, pB1, m_reg, mnB, alB); __syncthreads(); RESC(alB);
        finishSM(pB0, pB1, alB, l_reg, pa0, pa1, pa2, pa3); SBAR(); pv_tile<1>(o, vb0, pa0, pa1, pa2, pa3); }
    SBAR(); SEAM_K0();
    if (hi == 0) li_l[r32] = l_reg; asm volatile("s_waitcnt lgkmcnt(0)" ::: "memory");
    if (wid * QBLK < cur.nvalid) {
        float rli[16];
#pragma unroll
        for (int r = 0; r < 16; ++r) rli[r] = __builtin_amdgcn_rcpf(li_l[crow(r, hi)]);
        typedef __attribute__((address_space(1))) bf16_t gbf16_t;
        gbf16_t* Ow = (gbf16_t*)(cur.O + (size_t)(wid * QBLK + 4 * hi) * g.ldo + r32); const gbf16_t* Gw = (const gbf16_t*)(cur.G + (size_t)(wid * QBLK + 4 * hi) * g.ldg + r32);
        asm volatile("" : "+v"(Ow), "+v"(Gw));
#pragma unroll
        for (int r = 0; r < 16; ++r) { const int orow = (r & 3) + 8 * (r >> 2);
            float gv[4];
#pragma unroll
            for (int d0 = 0; d0 < 4; ++d0) gv[d0] = __uint_as_float((unsigned)Gw[(size_t)orow * g.ldg + d0 * 32] << 16);
#pragma unroll
            for (int d0 = 0; d0 < 4; ++d0) { const float v = o[d0][r] * rli[r] * gv[d0]; Ow[(size_t)orow * g.ldo + d0 * 32] = (bf16_t)(cvtpk(v, v) & 0xffffu); } }
    }
    __syncthreads();
#undef RESC
#undef KBASE
#undef MASKT
#undef SEAM_K0
#undef HALF_STEP
}
#undef ROW
#undef KSEL
#undef VSEL
#undef VMW
#undef VMWN
#undef SLOAD_H
#undef SWRITE_HK
#undef SWRITE_HV
#undef SWRITE_H
#undef SLOAD_F
#undef SWRITE_KF
#undef SWRITE_VF
#undef QROWP
#undef KSWZ
#undef SBAR
}
#define GAS __attribute__((address_space(1)))
#define LAS __attribute__((address_space(3)))
typedef unsigned short bf16;
typedef unsigned v4u __attribute__((ext_vector_type(4)));
typedef float f32x4 __attribute__((ext_vector_type(4)));
typedef short bf16x8 __attribute__((ext_vector_type(8)));
typedef GAS unsigned gu32;
typedef GAS unsigned long long gu64;
#define RLX_AGENT __ATOMIC_RELAXED, __HIP_MEMORY_SCOPE_AGENT
#define LDS_WAIT() asm volatile("s_waitcnt lgkmcnt(0)" ::: "memory")
#define VM_WAIT() asm volatile("s_waitcnt vmcnt(0)" ::: "memory")
__device__ __forceinline__ unsigned long long rt() { return __builtin_amdgcn_s_memrealtime(); }
__device__ __forceinline__ unsigned f2bf(float f) { unsigned u = __builtin_bit_cast(unsigned, f); return (u + 0x7fffu + ((u >> 16) & 1u)) >> 16; }
__device__ __forceinline__ unsigned pk2(float lo, float hi) { return f2bf(lo) | (f2bf(hi) << 16); }

#define XB_TMO      128
#define XB_XCNT(j)  (256  + 64 * (j))
#define XB_XSUB(j)  (1280 + 64 * (j))
#define XB_XGEN(j)  (2304 + 64 * (j))
#define XB_TOP      3328
#define XB_TOPGEN   3392
#define XCD_BAR_WORDS 3456
#define XB_SPIN_CAP (1u << 18)

__device__ __forceinline__ unsigned xb_ld(unsigned* p)              { return __hip_atomic_load(p, __ATOMIC_RELAXED, __HIP_MEMORY_SCOPE_AGENT); }
__device__ __forceinline__ unsigned xb_add(unsigned* p, unsigned v) { return __hip_atomic_fetch_add(p, v, __ATOMIC_RELAXED, __HIP_MEMORY_SCOPE_AGENT); }
__device__ __forceinline__ unsigned xb_xcc_id() { return (unsigned)__builtin_amdgcn_s_getreg((3 << 11) | 20) & 0xFu; }
#define XB_SPIN(cond, bar) do { unsigned _sp = 0; while (cond) { __builtin_amdgcn_s_sleep(1); \
    if ((++_sp & 255u) == 0u) { if (xb_ld(&(bar)[XB_TMO])) break; if (_sp > XB_SPIN_CAP) { atomicAdd(&(bar)[XB_TMO], 1u); break; } } } } while (0)

struct XcdBarrier {
    unsigned* bar; unsigned x;
    volatile LAS unsigned* st;
};

__device__ __forceinline__ XcdBarrier xcd_barrier_post(unsigned* bar, volatile LAS unsigned* st) {
    XcdBarrier b; b.bar = bar; b.x = xb_xcc_id(); b.st = st;
    if (threadIdx.x == 0) (void)xb_add(&bar[XB_XCNT(b.x)], 1u);
    return b;
}
__device__ __forceinline__ void xcd_barrier_complete(unsigned* bar, unsigned x, unsigned& nloc, unsigned& nx) {
    const unsigned G = gridDim.x * gridDim.y * gridDim.z;
    unsigned sum, cnt, mine, sp = 0u;
    for (;;) {
        sum = 0u; cnt = 0u; mine = 0u;
#pragma unroll
        for (unsigned j = 0; j < 16; ++j) { const unsigned c = xb_ld(&bar[XB_XCNT(j)]); sum += c; cnt += (c > 0u) ? 1u : 0u; mine = (j == x) ? c : mine; }
        if (sum == G) break;
        __builtin_amdgcn_s_sleep(1);
        if ((++sp & 255u) == 0u) { if (xb_ld(&bar[XB_TMO])) break; if (sp > XB_SPIN_CAP) { atomicAdd(&bar[XB_TMO], 1u); break; } }
    }
    nloc = mine > 0u ? mine : 1u; nx = cnt > 0u ? cnt : 1u;
}

__device__ __forceinline__ void xcd_barrier(const XcdBarrier& b) {
    asm volatile("s_waitcnt vmcnt(0)" ::: "memory");
    __syncthreads();
    if (threadIdx.x == 0) {
        unsigned* bar = b.bar;
        __builtin_amdgcn_s_waitcnt(0);
        unsigned nloc = b.st[0], nx = b.st[1];
        if (nloc == 0u) { xcd_barrier_complete(bar, b.x, nloc, nx); b.st[0] = nloc; b.st[1] = nx; }
        const unsigned old = xb_add(&bar[XB_XSUB(b.x)], 1u);
        const unsigned gen = old / nloc;
        if (old + 1u == (gen + 1u) * nloc) {
            __builtin_amdgcn_fence(__ATOMIC_RELEASE, "agent");
            asm volatile("s_waitcnt vmcnt(0)" ::: "memory");
            const unsigned og = xb_add(&bar[XB_TOP], 1u);
            const unsigned tg = og / nx;
            if (og + 1u == (tg + 1u) * nx) xb_add(&bar[XB_TOPGEN], 1u);
            else XB_SPIN(xb_ld(&bar[XB_TOPGEN]) == tg, bar);
            __builtin_amdgcn_fence(__ATOMIC_ACQUIRE, "agent");
            xb_add(&bar[XB_XGEN(b.x)], 1u);
            asm volatile("s_waitcnt vmcnt(0)" ::: "memory");
        } else {
            XB_SPIN(xb_ld(&bar[XB_XGEN(b.x)]) == gen, bar);
            __builtin_amdgcn_fence(__ATOMIC_ACQUIRE, "agent");
            asm volatile("s_waitcnt vmcnt(0)" ::: "memory");
        }
    }
    __syncthreads();
}

constexpr int NWAVES = 8;
constexpr int RING_OFF = 0, RING_BYTES = 131072;
constexpr int LDSCTL_OFF = RING_BYTES, MISC_OFF = LDSCTL_OFF + 320;
constexpr int LDS_BYTES = 147456;
static_assert(MISC_OFF + 128 <= LDS_BYTES && fa::LDS_BYTES <= RING_BYTES && pg8::STAGE_BYTES <= RING_BYTES, "LDS map");
constexpr int N_PHASES = 9;
constexpr int N_LAUNCHES = MK_N_LAUNCHES;

struct Args { const float* in[20]; float* out; unsigned char* ws; int ph_lo, ph_hi; };
static_assert(sizeof(Args) == 22 * 8 + 8, "Args has no padding");

__device__ __forceinline__ float wave_sum(float v) {
#pragma unroll
    for (int o = 1; o < 64; o <<= 1) v += __shfl_xor(v, o);
    return v;
}
__device__ __forceinline__ float bf_lo(unsigned u) { return __uint_as_float(u << 16); }
__device__ __forceinline__ float bf_hi(unsigned u) { return __uint_as_float(u & 0xffff0000u); }

__device__ __forceinline__ int p8_row(int l) { const int w = l & 31, fq = w >> 3, n = (w >> 2) & 1, i = w & 3; return (l & ~31) + 16 * n + 4 * fq + i; }
__device__ __forceinline__ int wa_row(int n) {
    if (n >= 4 * CD) return p8_row(n);
    const int qi = n / CD, c = n % CD, pn = c >> 6, ch = c & 63, wc = ch >> 4, fq = (ch >> 2) & 3, i = ch & 3, bj = qi >> 1, nn = qi & 1;
    return 256 * pn + 128 * bj + 32 * wc + 16 * nn + 4 * fq + i;
}
template <int MODE>
__device__ __forceinline__ void p0_transpose_item(const float* W, int ldw, const float* gain, bf16* WT, int row_off, LAS float* scr, int k0, int n0, int lane) {
#pragma unroll 8
    for (int i = 0; i < 32; ++i) { const int kk = 2 * i + (lane >> 5); scr[kk * 33 + (lane & 31)] = W[(size_t)(k0 + kk) * ldw + n0 + (lane & 31)] * (gain ? gain[k0 + kk] : 1.0f); }
    LDS_WAIT(); asm volatile("" ::: "memory");
    const int c = lane & 7;
#pragma unroll
    for (int j = 0; j < 4; ++j) { const int n = (lane >> 3) + 8 * j; const LAS float* s = scr + (8 * c) * 33 + n;
        v4u o; o.x = pk2(s[0 * 33], s[1 * 33]); o.y = pk2(s[2 * 33], s[3 * 33]); o.z = pk2(s[4 * 33], s[5 * 33]); o.w = pk2(s[6 * 33], s[7 * 33]);
        const int dr = MODE == 1 ? wa_row(n0 + n) : row_off + p8_row(n0 + n);
        *(GAS v4u*)(WT + (size_t)dr * DM + k0 + 8 * c) = o; }
    LDS_WAIT(); asm volatile("" ::: "memory");
}
__device__ __forceinline__ void rms_row_to_bf16(const float* xrow, bf16* orow, int lane) {
    const GAS f32x4* xr = (const GAS f32x4*)xrow + lane;
    f32x4 v[8]; float s = 0.f;
#pragma unroll
    for (int j = 0; j < 8; ++j) { v[j] = xr[64 * j]; s += (v[j].x * v[j].x + v[j].y * v[j].y) + (v[j].z * v[j].z + v[j].w * v[j].w); }
    const float rstd = 1.0f / sqrtf(wave_sum(s) * (1.f / DM) + EPS);
    GAS unsigned long long* o8 = (GAS unsigned long long*)orow + lane;
#pragma unroll
    for (int j = 0; j < 8; ++j) o8[64 * j] = (unsigned long long)pk2(v[j].x * rstd, v[j].y * rstd) | ((unsigned long long)pk2(v[j].z * rstd, v[j].w * rstd) << 32);
}
__device__ __forceinline__ float log_sigmoid(float v) { return v >= 0.f ? -log1pf(expf(-v)) : v - log1pf(expf(v)); }

__global__ void __launch_bounds__(NWAVES * 64, 2) yoco_fwd(Args args) {
    extern __shared__ __attribute__((aligned(16))) unsigned char lds[];
    LAS unsigned char* const ldsl = (LAS unsigned char*)lds;
    volatile LAS unsigned* const MISC = (volatile LAS unsigned*)(ldsl + MISC_OFF);
    const int wave = __builtin_amdgcn_readfirstlane(threadIdx.x >> 6);
    const int G = gridDim.x; const int bx = blockIdx.x; const int vcu = (G % 8 == 0) ? (bx % 8) * (G / 8) + bx / 8 : bx;
    const int gw = vcu * NWAVES + wave, NGW = G * NWAVES;
    gu32* const ctl = (gu32*)(args.ws + WS_CTL);
#define LANE() ((int)__builtin_amdgcn_mbcnt_hi(~0u, __builtin_amdgcn_mbcnt_lo(~0u, 0u)))
#define PHASE_ENV() const __attribute__((address_space(4))) Args* ap = (const __attribute__((address_space(4))) Args*)__builtin_amdgcn_kernarg_segment_ptr(); asm volatile("" : "+s"(ap)); \
    unsigned char* const ws = ap->ws; float* const dout = ap->out; int tid = threadIdx.x; asm volatile("" : "+v"(tid)); const int lane = tid & 63; (void)ws; (void)dout; (void)lane
#define INP(k) (ap->in[k])
#define WSP(T, off) ((T*)(ws + (off)))

    for (int u = threadIdx.x; u < (LDS_BYTES - LDSCTL_OFF) / 4; u += NWAVES * 64) ((LAS unsigned*)(ldsl + LDSCTL_OFF))[u] = 0u;
    __syncthreads();
    XcdBarrier bar; bar.bar = (unsigned*)(ctl + CW_BAR); bar.x = 0; bar.st = nullptr;
    if (N_LAUNCHES == 1) bar = xcd_barrier_post((unsigned*)(ctl + CW_BAR), MISC + 8);
#define GRID_BAR() do { if (N_LAUNCHES == 1) xcd_barrier(bar); } while (0)
    const int lo = args.ph_lo, hi = args.ph_hi;
#ifndef PH_MASK
#define PH_MASK 0x1ff
#endif
#define IN(k) ((((PH_MASK) >> (k)) & 1) && lo <= (k) && (k) < hi)
#define BOTH(k) (IN(k) && IN((k) + 1))

    if (IN(0)) {
        PHASE_ENV();
        const float* x_prompt = INP(0); const float* x_sample = INP(1); const float* cache_mem_k = INP(6); const float* cache_mem_v = INP(7); const float* mem_prompt = INP(8); const float* g_norm = INP(9);
        const float* w_in_a = INP(10); const float* w_in_b = INP(12); const float* w_out = INP(13); const float* g_mem = INP(14); const float* w_mem_kv = INP(15); const float* g_kv = INP(16); const float* w_kvf = INP(17);
        bf16* const WA = WSP(bf16, WS_WA); bf16* const WB = WSP(bf16, WS_WB); bf16* const WO = WSP(bf16, WS_WO); float* const WF = WSP(float, WS_WF); bf16* const XN = WSP(bf16, WS_XN); bf16* const MEMK = WSP(bf16, WS_MEMK); bf16* const MEMV = WSP(bf16, WS_MEMV);
        LAS float* scr = (LAS float*)(ldsl + RING_OFF + wave * 16384);
        constexpr int KB_ = DM / 64;
        constexpr int I_A = KB_ * (INA / 32), I_KV = KB_ * (2 * CD / 32), I_B = KB_ * (INB / 32), I_O = KB_ * (DM / 32), I_M = KB_ * (2 * MD / 32);
        constexpr int NITEMS = I_A + I_KV + I_B + 2 * I_O + 2 * I_M;
        for (int it = gw; it < NITEMS; it += NGW) {
            int r = it;
            if (r < I_A) { p0_transpose_item<1>(w_in_a, INA, g_norm, WA, 0, scr, 64 * (r / (INA / 32)), 32 * (r % (INA / 32)), lane); continue; } r -= I_A;
            if (r < I_KV) { p0_transpose_item<0>(w_kvf, KVF, g_kv, WB, 0, scr, 64 * (r / (2 * CD / 32)), 32 * (r % (2 * CD / 32)), lane); continue; } r -= I_KV;
            if (r < I_B) { p0_transpose_item<0>(w_in_b, INB, g_norm + DM, WB, 2 * CD, scr, 64 * (r / (INB / 32)), 32 * (r % (INB / 32)), lane); continue; } r -= I_B;
            if (r < 2 * I_O) { const int l = r / I_O; r -= l * I_O; p0_transpose_item<0>(w_out + (size_t)l * DM * DM, DM, nullptr, WO + (size_t)l * DM * DM, 0, scr, 64 * (r / (DM / 32)), 32 * (r % (DM / 32)), lane); continue; } r -= 2 * I_O;
            { const int l = r / I_M; r -= l * I_M; p0_transpose_item<0>(w_mem_kv + (size_t)l * DM * 2 * MD, 2 * MD, g_mem + l * DM, WA + (size_t)(INA + l * 2 * MD) * DM, 0, scr, 64 * (r / (2 * MD / 32)), 32 * (r % (2 * MD / 32)), lane); }
        }
        for (int m = gw; m < MT + PB * NMEM; m += NGW) {
            const float* src = m < MP ? x_prompt + (size_t)m * DM : (m < MT ? x_sample + (size_t)(m - MP) * DM : mem_prompt + (size_t)(m - MT) * DM);
            rms_row_to_bf16(src, XN + (size_t)m * DM, lane);
        }
        { constexpr int PER = NMEM * MD / 8;
          for (int i = gw * 64 + lane; i < 2 * 2 * SB * PER; i += NGW * 64) {
              const int kv = i / (2 * SB * PER), r = i % (2 * SB * PER), lb = r / PER, e = r % PER, layer = lb / SB, b = lb % SB;
              const float* src = (kv ? cache_mem_v : cache_mem_k) + ((size_t)lb * PER + e) * 8; bf16* dst = (kv ? MEMV : MEMK) + ((size_t)(layer * NMB + PB + b) * PER + e) * 8;
              const f32x4 a = *(const f32x4*)src, c = *(const f32x4*)(src + 4); v4u o; o.x = pk2(a.x, a.y); o.y = pk2(a.z, a.w); o.z = pk2(c.x, c.y); o.w = pk2(c.z, c.w); *(v4u*)dst = o; } }
        for (int i = gw * 64 + lane; i < NHF * DM; i += NGW * 64) { const int j = i / DM, k = i % DM; WF[i] = g_kv[k] * w_kvf[(size_t)k * KVF + 2 * CD + j]; }
        if (BOTH(0)) GRID_BAR();
    }

    if (IN(1)) {
        PHASE_ENV();
        bf16* const XN = WSP(bf16, WS_XN); bf16* const WA = WSP(bf16, WS_WA);
        pg8::Gemm g{XN, WA, MT + PB * NMEM, INA + 4 * MD, DM}; pg8::GridOrder S; S.init(MT / 256, INA / 256, G, bx, 16, MT / 256, INA / 256, 8);
        pg8::EpiA E{WSP(bf16, WS_CU), WSP(bf16, WS_BZ), WSP(bf16, WS_QM), WSP(bf16, WS_SZM), WSP(bf16, WS_MEMK), WSP(bf16, WS_MEMV), dout};
        pg8::gemm_phase<pg8::EpiA, pg8::GridOrder, true, true>(ldsl + RING_OFF, g, S, E);
        if (BOTH(1)) GRID_BAR();
    }

    if (IN(2)) {
        PHASE_ENV();
        const float* state_conv = INP(2); const float* conv_w = INP(11);
        bf16* const CUb = WSP(bf16, WS_CU); bf16* const BZb = WSP(bf16, WS_BZ); bf16* const QMb = WSP(bf16, WS_QM); bf16* const SZMb = WSP(bf16, WS_SZM); bf16* const MIX = WSP(bf16, WS_MIX); bf16* const MEMK = WSP(bf16, WS_MEMK); bf16* const MEMV = WSP(bf16, WS_MEMV);
        for (int it = gw; it < (MT / 32) * 3; it += NGW) {
            const int rc = it / 3, cc = it % 3, r0 = rc * 32, c0 = cc * 512 + lane * 8;
            float w0[8], w1[8], w2[8];
#pragma unroll
            for (int j = 0; j < 8; ++j) { w0[j] = conv_w[c0 + j]; w1[j] = conv_w[CD + c0 + j]; w2[j] = conv_w[2 * CD + c0 + j]; }
            float h2[8], h1[8];
            const bool pr = r0 < MP; const int t0 = pr ? (r0 & (PT - 1)) : ((r0 - MP) & (ST - 1));
            if (t0 == 0) {
                if (pr) {
#pragma unroll
                    for (int j = 0; j < 8; ++j) { h2[j] = 0.f; h1[j] = 0.f; } }
                else { const float* sp = state_conv + (size_t)((r0 - MP) / ST) * 2 * CD + c0;
#pragma unroll
                    for (int j = 0; j < 8; ++j) { h2[j] = sp[j]; h1[j] = sp[CD + j]; } }
            } else {
                const v4u a = *(const v4u*)(CUb + (size_t)(r0 - 2) * CD + c0), b = *(const v4u*)(CUb + (size_t)(r0 - 1) * CD + c0);
                h2[0] = bf_lo(a.x); h2[1] = bf_hi(a.x); h2[2] = bf_lo(a.y); h2[3] = bf_hi(a.y); h2[4] = bf_lo(a.z); h2[5] = bf_hi(a.z); h2[6] = bf_lo(a.w); h2[7] = bf_hi(a.w);
                h1[0] = bf_lo(b.x); h1[1] = bf_hi(b.x); h1[2] = bf_lo(b.y); h1[3] = bf_hi(b.y); h1[4] = bf_lo(b.z); h1[5] = bf_hi(b.z); h1[6] = bf_lo(b.w); h1[7] = bf_hi(b.w);
            }
#pragma unroll 4
            for (int r = 0; r < 32; ++r) {
                const v4u a = *(const v4u*)(CUb + (size_t)(r0 + r) * CD + c0), b = *(const v4u*)(BZb + (size_t)(r0 + r) * CD + c0);
                float cu[8], bz[8], o[8];
                cu[0] = bf_lo(a.x); cu[1] = bf_hi(a.x); cu[2] = bf_lo(a.y); cu[3] = bf_hi(a.y); cu[4] = bf_lo(a.z); cu[5] = bf_hi(a.z); cu[6] = bf_lo(a.w); cu[7] = bf_hi(a.w);
                bz[0] = bf_lo(b.x); bz[1] = bf_hi(b.x); bz[2] = bf_lo(b.y); bz[3] = bf_hi(b.y); bz[4] = bf_lo(b.z); bz[5] = bf_hi(b.z); bz[6] = bf_lo(b.w); bz[7] = bf_hi(b.w);
#pragma unroll
                for (int j = 0; j < 8; ++j) { o[j] = bz[j] * (w0[j] * h2[j] + w1[j] * h1[j] + w2[j] * cu[j]); h2[j] = h1[j]; h1[j] = cu[j]; }
                v4u w; w.x = pk2(o[0], o[1]); w.y = pk2(o[2], o[3]); w.z = pk2(o[4], o[5]); w.w = pk2(o[6], o[7]);
                *(v4u*)(MIX + (size_t)(r0 + r) * DM + c0) = w;
            }
        }
        {
            for (int i = tid; i < 256; i += NWAVES * 64) ((LAS float*)(ldsl + RING_OFF + fa::LDS_BIAS))[i] = 0.f;
            __syncthreads();
            const fa::Geom gm{MD, MD, DM, MD, 0x7fffffff};
            auto mk = [=](int idx) { const int blk = idx >> 2, h = idx & 3; const bool pr = blk < 64; const int row0 = pr ? blk * 256 : MP + (blk - 64) * ST, mb = pr ? (blk >> 5) : PB + (blk - 64);
                fa::BlockRef<fa::bf16_t> r; r.Q = QMb + (size_t)row0 * MD + h * HD; r.K = MEMK + (size_t)(0 * NMB + mb) * NMEM * MD + h * HD; r.V = MEMV + (size_t)(0 * NMB + mb) * NMEM * MD + h * HD; r.K2 = r.K; r.V2 = r.V;
                r.O = MIX + (size_t)row0 * DM + CD + h * HD; r.G = SZMb + (size_t)row0 * MD + h * HD; r.bias = nullptr; r.P0 = 1 << 20; r.skv = NMEM; r.nvalid = pr ? 256 : ST; return r; };
            if (vcu < 320) {
                fa::Seam<fa::bf16_t> Sm; fa::BlockRef<fa::bf16_t> cur = mk(vcu); fa::attn_prime<fa::bf16_t>(cur, gm, (char*)lds + RING_OFF, Sm);
                for (int idx = vcu; idx < 320; idx += G) { const bool more = idx + G < 320; const fa::BlockRef<fa::bf16_t> nxt = more ? mk(idx + G) : cur;
                    fa::attn_block<fa::bf16_t>(cur, nxt, gm, (char*)lds + RING_OFF, Sm); cur = nxt; }
            }
        }
        if (BOTH(2)) GRID_BAR();
    }

    if (IN(3)) {
        PHASE_ENV();
        const float* x_prompt = INP(0); const float* x_sample = INP(1); bf16* const MIX = WSP(bf16, WS_MIX); bf16* const WO = WSP(bf16, WS_WO); float* const X1 = WSP(float, WS_X1);
        pg8::Gemm g{MIX, WO, MT, DM, DM}; pg8::GridOrder S; S.init(MT / 256, DM / 256, G, bx);
        pg8::EpiO E{x_prompt, x_sample - (size_t)MP * DM, X1};
        pg8::gemm_phase<pg8::EpiO, pg8::GridOrder, true, true>(ldsl + RING_OFF, g, S, E);
        if (BOTH(3)) GRID_BAR();
    }

    if (IN(4)) {
        PHASE_ENV();
        const float* b_f = INP(18); float* const WF = WSP(float, WS_WF); bf16* const XN = WSP(bf16, WS_XN); float* const X1 = WSP(float, WS_X1);
        LAS f32x4* wfl = (LAS f32x4*)(ldsl + RING_OFF);
        for (int i = tid; i < NHF * DM / 4; i += NWAVES * 64) wfl[i] = ((const f32x4*)WF)[i];
        __syncthreads();
        for (int m = gw; m < MT; m += NGW) {
            const GAS f32x4* xr = (const GAS f32x4*)(X1 + (size_t)m * DM) + lane;
            f32x4 v[8]; float s = 0.f;
#pragma unroll
            for (int j = 0; j < 8; ++j) { v[j] = xr[64 * j]; s += (v[j].x * v[j].x + v[j].y * v[j].y) + (v[j].z * v[j].z + v[j].w * v[j].w); }
            const float rstd = 1.0f / sqrtf(wave_sum(s) * (1.f / DM) + EPS);
#pragma unroll
            for (int j = 0; j < 8; ++j) v[j] = v[j] * rstd;
            GAS unsigned long long* o8 = (GAS unsigned long long*)(XN + (size_t)m * DM) + lane;
#pragma unroll
            for (int j = 0; j < 8; ++j) o8[64 * j] = (unsigned long long)pk2(v[j].x, v[j].y) | ((unsigned long long)pk2(v[j].z, v[j].w) << 32);
            float mine = 0.f;
#pragma unroll 1
            for (int hh = 0; hh < NHF; ++hh) { float d = 0.f;
#pragma unroll
                for (int j = 0; j < 8; ++j) { const f32x4 w = wfl[hh * (DM / 4) + 64 * j + lane]; d += (v[j].x * w.x + v[j].y * w.y) + (v[j].z * w.z + v[j].w * w.w); }
                d = wave_sum(d); if (lane == hh) mine = d; }
            if (lane < NHF) { const float lf = log_sigmoid(mine + b_f[lane]);
                if (m < MP) dout[OO_PLOGF + (size_t)m * NHF + lane] = lf; else dout[OO_SLOGF + (size_t)(m - MP) * NHF + lane] = lf; }
        }
        __syncthreads();
        if (BOTH(4)) GRID_BAR();
    }

    if (IN(5)) {
        PHASE_ENV();
        const float* cache_logf = INP(5); bf16* const XN = WSP(bf16, WS_XN); bf16* const WB = WSP(bf16, WS_WB); float* const KBIAS = WSP(float, WS_KBIAS);
        pg8::Gemm g{XN, WB, MT, INA, DM}; pg8::GridOrder S; S.init(MT / 256, INA / 256, G, bx);
        pg8::EpiB E{ws, dout};
        pg8::gemm_phase<pg8::EpiB, pg8::GridOrder, true, true>(ldsl + RING_OFF, g, S, E);
        const int sq = bx - (G - NMB);
        if (sq >= 0) {
            LAS float* tot = (LAS float*)(ldsl + RING_OFF);
            const bool pr = sq < PB; const int len = pr ? PT : SKV_S; const int t0 = tid * 16; const bool actv = t0 < len;
            const float* src = nullptr;
            if (actv) { if (pr) src = dout + OO_PLOGF + ((size_t)sq * PT + t0) * NHF; else { const int b = sq - PB; src = t0 < PAST ? cache_logf + ((size_t)b * PAST + t0) * NHF : dout + OO_SLOGF + ((size_t)b * ST + (t0 - PAST)) * NHF; } }
            float sum[NHF];
#pragma unroll
            for (int hh = 0; hh < NHF; ++hh) sum[hh] = 0.f;
            if (actv) {
#pragma unroll 4
                for (int r = 0; r < 16; ++r) { const f32x4 a = *(const f32x4*)(src + r * NHF), b = *(const f32x4*)(src + r * NHF + 4), c = *(const f32x4*)(src + r * NHF + 8);
                    sum[0] += a.x; sum[1] += a.y; sum[2] += a.z; sum[3] += a.w; sum[4] += b.x; sum[5] += b.y; sum[6] += b.z; sum[7] += b.w; sum[8] += c.x; sum[9] += c.y; sum[10] += c.z; sum[11] += c.w; } }
            float off[NHF];
#pragma unroll
            for (int hh = 0; hh < NHF; ++hh) { float inc = sum[hh];
#pragma unroll
                for (int o = 1; o < 64; o <<= 1) { const float n = __shfl_up(inc, o); if (lane >= o) inc += n; }
                off[hh] = inc - sum[hh]; if (lane == 63) tot[wave * NHF + hh] = inc; }
            __syncthreads();
#pragma unroll
            for (int hh = 0; hh < NHF; ++hh) { float base = 0.f; for (int w = 0; w < wave; ++w) base += tot[w * NHF + hh]; off[hh] += base; }
            if (actv) {
                float* dst = KBIAS + (pr ? (size_t)sq * NHF * PT : KBIAS_S_OFF + (size_t)(sq - PB) * NHF * SKV_S) + t0; const float ns = -1.0f / fa::SCALE;
                float run[NHF];
#pragma unroll
                for (int hh = 0; hh < NHF; ++hh) run[hh] = off[hh];
#pragma unroll 4
                for (int r = 0; r < 16; ++r) { const f32x4 a = *(const f32x4*)(src + r * NHF), b = *(const f32x4*)(src + r * NHF + 4), c = *(const f32x4*)(src + r * NHF + 8);
                    run[0] += a.x; run[1] += a.y; run[2] += a.z; run[3] += a.w; run[4] += b.x; run[5] += b.y; run[6] += b.z; run[7] += b.w; run[8] += c.x; run[9] += c.y; run[10] += c.z; run[11] += c.w;
#pragma unroll
                    for (int hh = 0; hh < NHF; ++hh) dst[(size_t)hh * len + r] = run[hh] * ns; }
            }
            __syncthreads();
        }
        if (BOTH(5)) GRID_BAR();
    }

    if (IN(6)) {
        PHASE_ENV();
        const float* cache_k = INP(3); const float* cache_v = INP(4);
        bf16* const QMb = WSP(bf16, WS_QM); bf16* const SZMb = WSP(bf16, WS_SZM); bf16* const MIX = WSP(bf16, WS_MIX); bf16* const KBb = WSP(bf16, WS_KB); bf16* const VBb = WSP(bf16, WS_VB);
        bf16* const QFb = WSP(bf16, WS_QF); bf16* const SZFb = WSP(bf16, WS_SZF); bf16* const MEMK = WSP(bf16, WS_MEMK); bf16* const MEMV = WSP(bf16, WS_MEMV); float* const KBIAS = WSP(float, WS_KBIAS);
        char* const al = (char*)lds + RING_OFF;
        {
            const fa::Geom gp{CD, CD, DM, CD, 0x7fffffff};
            const int xg = vcu >> 5, i = vcu & 31, ii = i & 15; const bool up = i >= 16;
            const int qbA = up ? 2 * ii + 1 : 2 * ii, qbB = up ? 15 - ii : 31 - ii, qbC = up ? 31 - ii : 15 - ii;
            auto mk = [=](int k) { const int bh = 3 * xg + k, qb = k == 0 ? qbA : (k == 1 ? qbB : qbC), b = bh / NHF, h = bh % NHF; const size_t row0 = (size_t)b * PT + (size_t)qb * 256;
                fa::BlockRef<fa::bf16_t> r; r.Q = QFb + row0 * CD + h * HD; r.K = KBb + (size_t)b * PT * CD + h * HD; r.V = VBb + (size_t)b * PT * CD + h * HD; r.K2 = r.K; r.V2 = r.V;
                r.O = MIX + row0 * DM + h * HD; r.G = SZFb + row0 * CD + h * HD; r.bias = KBIAS + (size_t)bh * PT; r.P0 = qb * 256; r.skv = PT; r.nvalid = 256; return r; };
            if (vcu < 256) {
                fa::Seam<fa::bf16_t> Sm; fa::BlockRef<fa::bf16_t> cur = mk(0); fa::attn_prime<fa::bf16_t>(cur, gp, al, Sm);
                for (int k = 0; k < 3; ++k) { const fa::BlockRef<fa::bf16_t> nxt = k < 2 ? mk(k + 1) : cur; fa::attn_block<fa::bf16_t>(cur, nxt, gp, al, Sm); cur = nxt; }
            }
        }
        {
            const fa::Geom gs{CD, CD, DM, CD, PAST};
            const int i = vcu & 31, su = (vcu >> 5) * 24 + i;
            if (vcu < 256 && i < 24) {
                const int b = su / NHF, h = su % NHF; const size_t row0 = (size_t)MP + (size_t)b * ST;
                fa::BlockRef<float> r; r.Q = QFb + row0 * CD + h * HD; r.K = cache_k + (size_t)b * PAST * CD + h * HD; r.V = cache_v + (size_t)b * PAST * CD + h * HD;
                r.K2 = dout + OO_SK + (size_t)b * ST * CD + h * HD - (size_t)PAST * CD; r.V2 = dout + OO_SV + (size_t)b * ST * CD + h * HD - (size_t)PAST * CD;
                r.O = MIX + row0 * DM + h * HD; r.G = SZFb + row0 * CD + h * HD; r.bias = KBIAS + KBIAS_S_OFF + (size_t)su * SKV_S; r.P0 = PAST; r.skv = SKV_S; r.nvalid = ST;
                fa::Seam<float> Sf; fa::attn_prime<float>(r, gs, al, Sf); fa::attn_block<float>(r, r, gs, al, Sf);
            }
        }
        {
            asm volatile("s_waitcnt vmcnt(0)" ::: "memory"); __syncthreads();
            for (int i = tid; i < 256; i += NWAVES * 64) ((LAS float*)(ldsl + RING_OFF + fa::LDS_BIAS))[i] = 0.f;
            __syncthreads();
            const fa::Geom gm{MD, MD, DM, MD, 0x7fffffff};
            auto mk = [=](int idx) { const int blk = idx >> 2, h = idx & 3; const bool pr = blk < 64; const int row0 = pr ? blk * 256 : MP + (blk - 64) * ST, mb = pr ? (blk >> 5) : PB + (blk - 64);
                fa::BlockRef<fa::bf16_t> r; r.Q = QMb + (size_t)row0 * MD + h * HD; r.K = MEMK + (size_t)(1 * NMB + mb) * NMEM * MD + h * HD; r.V = MEMV + (size_t)(1 * NMB + mb) * NMEM * MD + h * HD; r.K2 = r.K; r.V2 = r.V;
                r.O = MIX + (size_t)row0 * DM + CD + h * HD; r.G = SZMb + (size_t)row0 * MD + h * HD; r.bias = nullptr; r.P0 = 1 << 20; r.skv = NMEM; r.nvalid = pr ? 256 : ST; return r; };
            const int i = vcu & 31;
            if (vcu < 256 && i >= 24) {
                const int base = ((vcu >> 5) * 8 + (i - 24)) * 5;
                fa::Seam<fa::bf16_t> Sm; fa::BlockRef<fa::bf16_t> cur = mk(base); fa::attn_prime<fa::bf16_t>(cur, gm, al, Sm);
                for (int k = 0; k < 5; ++k) { const fa::BlockRef<fa::bf16_t> nxt = k < 4 ? mk(base + k + 1) : cur; fa::attn_block<fa::bf16_t>(cur, nxt, gm, al, Sm); cur = nxt; }
            }
        }
        if (BOTH(6)) GRID_BAR();
    }

    if (IN(7)) {
        PHASE_ENV();
        bf16* const MIX = WSP(bf16, WS_MIX); bf16* const WO = WSP(bf16, WS_WO); float* const X1 = WSP(float, WS_X1);
        pg8::Gemm g{MIX, WO + (size_t)DM * DM, MT, DM, DM}; pg8::GridOrder S; S.init(MT / 256, DM / 256, G, bx);
        pg8::EpiO E{X1, X1, dout + OO_Y};
        pg8::gemm_phase<pg8::EpiO, pg8::GridOrder, true, true>(ldsl + RING_OFF, g, S, E);
        if (BOTH(7)) GRID_BAR();
    }

    if (IN(8)) {
        PHASE_ENV();
        const float* g_final = INP(19);
        f32x4 gf[8];
#pragma unroll
        for (int j = 0; j < 8; ++j) gf[j] = ((const f32x4*)g_final)[64 * j + lane];
        for (int m = gw; m < MT; m += NGW) {
            GAS f32x4* xr = (GAS f32x4*)(dout + OO_Y + (size_t)m * DM) + lane;
            f32x4 v[8]; float s = 0.f;
#pragma unroll
            for (int j = 0; j < 8; ++j) { v[j] = xr[64 * j]; s += (v[j].x * v[j].x + v[j].y * v[j].y) + (v[j].z * v[j].z + v[j].w * v[j].w); }
            const float rstd = 1.0f / sqrtf(wave_sum(s) * (1.f / DM) + EPS);
#pragma unroll
            for (int j = 0; j < 8; ++j) xr[64 * j] = v[j] * rstd * gf[j];
        }
    }
#undef IN
#undef BOTH
#undef GRID_BAR
}

extern "C" void kernel_launch(void* const* d_in, const int* in_sizes, int n_in, void* d_out, int out_size, void* d_ws, size_t ws_size, hipStream_t stream) {
    static int grid = 0;
    if (grid == 0) {
        if (n_in != 20 || (size_t)out_size != OUT_TOTAL || ws_size < WS_END) { fprintf(stderr, "kernel_launch: shape mismatch (n_in %d, out %d want %zu, ws %zu want %zu); nothing launched\n", n_in, out_size, (size_t)OUT_TOTAL, ws_size, (size_t)WS_END); grid = -1; return; }
        int dev = 0, cus = 0, per_cu = 0;
        if (hipGetDevice(&dev) != hipSuccess || hipDeviceGetAttribute(&cus, hipDeviceAttributeMultiprocessorCount, dev) != hipSuccess) { fprintf(stderr, "kernel_launch: device query failed\n"); grid = -1; return; }
        if (hipFuncSetAttribute((const void*)yoco_fwd, hipFuncAttributeMaxDynamicSharedMemorySize, LDS_BYTES) != hipSuccess) { fprintf(stderr, "kernel_launch: hipFuncSetAttribute failed\n"); grid = -1; return; }
        if (hipOccupancyMaxActiveBlocksPerMultiprocessor(&per_cu, (const void*)yoco_fwd, NWAVES * 64, LDS_BYTES) != hipSuccess || per_cu < 1)
            fprintf(stderr, "kernel_launch: note: occupancy query reports %d workgroups per CU\n", per_cu);
        (void)hipGetLastError();
        grid = cus;
        if (grid != 256) fprintf(stderr, "kernel_launch: note: %d CUs (the static work deals assume 256)\n", grid);
    }
    if (grid < 0) return;
    if (hipMemsetAsync((char*)d_ws + WS_CTL, 0, CTL_ZERO_BYTES, stream) != hipSuccess) { fprintf(stderr, "kernel_launch: hipMemsetAsync failed\n"); return; }
    Args a{};
    for (int i = 0; i < 20; ++i) a.in[i] = (const float*)d_in[i];
    a.out = (float*)d_out; a.ws = (unsigned char*)d_ws;
    for (int li = 0; li < N_LAUNCHES; ++li) {
        if (N_LAUNCHES == 1) { a.ph_lo = 0; a.ph_hi = N_PHASES; } else { a.ph_lo = li * N_PHASES / N_LAUNCHES; a.ph_hi = (li + 1) * N_PHASES / N_LAUNCHES; }
        hipLaunchKernelGGL(yoco_fwd, dim3(grid), dim3(NWAVES * 64), LDS_BYTES, stream, a);
        const hipError_t le = hipPeekAtLastError();
        if (le != hipSuccess) { fprintf(stderr, "kernel_launch: launch %d failed: %s\n", li, hipGetErrorName(le)); break; }
    }
}
```

```cpp
#include <hip/hip_runtime.h>
#include <cstdio>
#include <cstdint>
#ifndef MK_N_LAUNCHES
#define MK_N_LAUNCHES 1
#endif
constexpr int DM = 2048, PB = 2, PT = 8192, SB = 16, ST = 64, PAST = 4096;
constexpr int MP = PB * PT, MS = SB * ST, MT = MP + MS;
constexpr int CD = 1536, NHF = 12, HD = 128, NMEM = 256, NHM = 4, MD = 512;
constexpr int INA = 7168, INB = 4096, KVF = 3084;
constexpr int LDK = DM;
__host__ __device__ __forceinline__ size_t ktm(int row, int col, int nrows) { return ((size_t)(col >> 6) * nrows + row) * 64 + (col & 63); }
constexpr int XN_ROWS = MT + PB * NMEM, WA_ROWS = INA + 4 * MD;
constexpr int SKV_S = PAST + ST;
constexpr float EPS = 1e-6f;
constexpr int NMB = PB + SB;
constexpr size_t OO_Y = 0;
constexpr size_t OO_PSTATE = OO_Y + (size_t)MT * DM;
constexpr size_t OO_PK = OO_PSTATE + (size_t)PB * 2 * CD;
constexpr size_t OO_PV = OO_PK + (size_t)MP * CD;
constexpr size_t OO_PLOGF = OO_PV + (size_t)MP * CD;
constexpr size_t OO_PMEMK = OO_PLOGF + (size_t)MP * NHF;
constexpr size_t OO_PMEMV = OO_PMEMK + (size_t)2 * PB * NMEM * MD;
constexpr size_t OO_SSTATE = OO_PMEMV + (size_t)2 * PB * NMEM * MD;
constexpr size_t OO_SK = OO_SSTATE + (size_t)SB * 2 * CD;
constexpr size_t OO_SV = OO_SK + (size_t)MS * CD;
constexpr size_t OO_SLOGF = OO_SV + (size_t)MS * CD;
constexpr size_t OUT_TOTAL = OO_SLOGF + (size_t)MS * NHF;
constexpr size_t MiB = 1u << 20;
constexpr size_t WS_CTL = 0, CTL_ZERO_BYTES = 2 * MiB;
constexpr size_t WS_WA = 2 * MiB;
constexpr size_t WS_WB = WS_WA + 40 * MiB;
constexpr size_t WS_WO = WS_WB + 30 * MiB;
constexpr size_t WS_WF = WS_WO + 18 * MiB;
constexpr size_t WS_RS = WS_WF + 512 * 1024;
constexpr size_t WS_RS0 = WS_WF + 640 * 1024;
constexpr size_t WS_XN = WS_WF + 1 * MiB;
constexpr size_t WS_X1 = WS_XN + 75 * MiB;
constexpr size_t WS_XU = WS_X1;
constexpr size_t WS_D1 = WS_X1, WS_D2 = WS_X1 + 68 * MiB;
constexpr size_t WS_CU = WS_X1 + 136 * MiB;
constexpr size_t WS_FCU = WS_CU, WS_FBZ = WS_CU + 4 * MiB, WS_LCU = WS_CU + 8 * MiB;
constexpr size_t WS_BZ = WS_CU + 51 * MiB;
constexpr size_t WS_QM = WS_BZ + 51 * MiB;
constexpr size_t WS_SZM = WS_QM + 17 * MiB;
constexpr size_t WS_MIX = WS_SZM + 17 * MiB;
constexpr size_t WS_KB = WS_MIX + 73 * MiB;
constexpr size_t WS_VB = WS_KB + 48 * MiB;
constexpr size_t WS_QF = WS_VB + 48 * MiB;
constexpr size_t WS_SZF = WS_QF + 51 * MiB;
constexpr size_t WS_MEMK = WS_SZF + 51 * MiB;
constexpr size_t WS_MEMV = WS_MEMK + 9 * MiB;
constexpr size_t WS_KBIAS = WS_MEMV + 9 * MiB;
constexpr size_t KBIAS_S_OFF = (size_t)PB * NHF * PT;
constexpr size_t WS_END = WS_KBIAS + 4 * MiB;
static_assert(WS_END < (size_t)1536 * MiB, "d_ws map");
static_assert((size_t)(MT + 512) * LDK * 2 <= 75 * MiB && (size_t)(INA + 4 * MD) * LDK * 2 <= 40 * MiB && (size_t)INA * LDK * 2 <= 30 * MiB && (size_t)2 * DM * LDK * 2 <= 18 * MiB && (size_t)MT * LDK * 2 <= 73 * MiB && (size_t)MT * CD * 2 <= 51 * MiB && (size_t)MT * DM * 4 <= 136 * MiB && (size_t)2 * NMB * NMEM * MD * 2 <= 9 * MiB, "d_ws map sizes");
static_assert((KBIAS_S_OFF + (size_t)SB * NHF * SKV_S) * 4 <= 4 * MiB, "kbias size");
constexpr int CW_TMO = 0, CW_CODE = 1;
constexpr int CW_BAR = 4096;
constexpr int CW_C1 = 3 * 4096, CW_C2 = CW_C1 + 64, CW_C3 = CW_C1 + 128;
constexpr int CW_QFOX = 8192, CW_QMEM = CW_QFOX + 64 * 8;
constexpr int CW_SS1 = 262144 + PB * NHF * PT;
constexpr int CW_KN2 = 262144;
static_assert((size_t)(CW_SS1 + MT) * 4 <= CTL_ZERO_BYTES && CTL_ZERO_BYTES <= WS_WA, "control words inside the memset");
namespace pg8 {
#define PG8_LAS __attribute__((address_space(3)))
typedef unsigned short bf16_t;
typedef short bf16x8 __attribute__((ext_vector_type(8)));
typedef float f32x4 __attribute__((ext_vector_type(4)));
typedef unsigned u32x4 __attribute__((ext_vector_type(4)));
constexpr int BM = 256, BK = 64, HALF = 128, HTB = HALF * BK * 2  , STAGE_BYTES = 8 * HTB, NXCD = 8, WGM = 8;

__host__ __device__ __forceinline__ int lds_byte(int r, int c) { const int st = (r >> 4) * 2 + (c >> 5), rr = r & 15, cc = c & 31, ob = rr * 64 + cc * 2; return st * 1024 + (ob ^ (((ob >> 9) & 1) << 5)); }
__host__ __device__ __forceinline__ void stage_rc(int b, int& R, int& C) { const int st = b / 1024, sb = b % 1024, swz = sb ^ (((sb >> 9) & 1) << 5); R = (st >> 1) * 16 + swz / 64; C = (st & 1) * 32 + (swz % 64) / 2; }
__host__ __device__ __forceinline__ int perm32(int rho) { const int n = rho >> 4, i = rho & 15; return 8 * (i >> 2) + 4 * n + (i & 3); }

struct Unit { int row0, pn, half; };
struct Gemm { const bf16_t* A; const bf16_t* Bt; int rowsA, rowsB, K; };
__device__ __forceinline__ unsigned cvt_pk_bf16(float lo, float hi) { unsigned r; asm volatile("v_cvt_pk_bf16_f32 %0, %1, %2" : "=v"(r) : "v"(lo), "v"(hi)); return r; }
typedef float f32x2 __attribute__((ext_vector_type(2)));

struct GridOrder {
    int nM, nN, nwg, G, c; int hN0, hRow00, hPn00, hNn0, hN1, hRow01, hPn01, hNn1; int hFull;
    int noFull;
    int subBase, subN;
    int deferBase;
    __device__ __forceinline__ void init(int nM_, int nN_, int G_, int c_, int hN0_ = 0, int hRow00_ = 0, int hPn00_ = 0, int hNn0_ = 1, int hN1_ = 0, int hRow01_ = 0, int hPn01_ = 0, int hNn1_ = 1) {
        nM = nM_; nN = nN_; nwg = nM * nN; G = G_; c = c_; hN0 = hN0_; hRow00 = hRow00_; hPn00 = hPn00_; hNn0 = hNn0_; hN1 = hN1_; hRow01 = hRow01_; hPn01 = hPn01_; hNn1 = hNn1_; hFull = 0; noFull = 0; subBase = 0; subN = 0; deferBase = -1; }
    __device__ __forceinline__ bool next(int i, Unit& u) const {
        const long L = (long)i * G + c; const int nfull = noFull ? 0 : nwg; if (L >= nfull + hN0 + hN1) return false;
        const bool hf = L >= nfull;
        int e = (int)L - nfull; const bool g1 = e >= hN0; e = g1 ? e - hN0 : e;
        const bool sub = !hf && L >= subBase && L < subBase + subN;
        const bool defer = hf && g1 && deferBase >= 0;
        const int ex = sub ? (int)L - subBase : e; const bool xg1 = sub || g1;
        const int hnn = xg1 ? hNn1 : hNn0, hrow = (xg1 ? hRow01 : hRow00) + (hFull ? 256 : 128) * (ex / hnn), hpn = (xg1 ? hPn01 : hPn00) + ex % hnn;
        int wgid = defer ? deferBase + e : (hf ? 0 : (int)L); { const int q = nwg / NXCD, r = nwg % NXCD, xcd = wgid % NXCD, off = wgid / NXCD; wgid = (xcd < r ? xcd * (q + 1) : r * (q + 1) + (xcd - r) * q) + off; }
        const int nig = WGM * nN, gid = wgid / nig, fm = gid * WGM; int gsz = (nM - fm) < WGM ? (nM - fm) : WGM; gsz = gsz < 1 ? 1 : gsz;
        const int frow = (fm + ((wgid % nig) % gsz)) * BM, fpn = (wgid % nig) / gsz;
        const bool useX = (hf && !defer) || sub;
        Unit r_; r_.row0 = useX ? hrow : frow; r_.pn = useX ? hpn : fpn; r_.half = (useX && !hFull) ? 1 : 0; u = r_; return true;
    }
    __device__ __forceinline__ void a_ready(const Unit&) const {}
    __device__ __forceinline__ void done(const Unit&) const {}
};

__device__ __forceinline__ float sigmoidf_(float z) { return __builtin_amdgcn_rcpf(1.0f + __builtin_amdgcn_exp2f(-1.4426950408889634f * z)); }
__device__ __forceinline__ f32x4 silu4(f32x4 z) { return (f32x4){z[0] * sigmoidf_(z[0]), z[1] * sigmoidf_(z[1]), z[2] * sigmoidf_(z[2]), z[3] * sigmoidf_(z[3])}; }
typedef unsigned u32x2 __attribute__((ext_vector_type(2)));
__device__ __forceinline__ u32x2 pk4(f32x4 v) { u32x2 w; w.x = cvt_pk_bf16(v[0], v[1]); w.y = cvt_pk_bf16(v[2], v[3]); return w; }
__device__ __forceinline__ u32x4 pk8(f32x4 a, f32x4 b) { u32x4 w; w.x = cvt_pk_bf16(a[0], a[1]); w.y = cvt_pk_bf16(a[2], a[3]); w.z = cvt_pk_bf16(b[0], b[1]); w.w = cvt_pk_bf16(b[2], b[3]); return w; }

struct EpiA {
    static constexpr bool PERM = false, AFTER_DRAIN = false;
    bf16_t *MIXo, *QMo, *SZMo, *MEMKo, *MEMVo; float* dout; float *FCU, *FBZ, *LCU; const float* convw;
    __device__ __forceinline__ void operator()(const f32x4 (&acc)[2][2][4][2], const Unit& u, int wr, int wc, int fr, int fq) const {
        const int nai = u.half ? 1 : 2;
        if (u.pn < 24) {
            const int ch0 = u.pn * 64 + wc * 16 + fq * 4;
            const f32x4 w0 = *(const f32x4*)(convw + ch0), w1 = *(const f32x4*)(convw + CD + ch0), w2 = *(const f32x4*)(convw + 2 * CD + ch0);
#define DPP_ROR(x, n) __int_as_float(__builtin_amdgcn_mov_dpp(__float_as_int(x), 0x120 + (n), 0xf, 0xf, false))
#pragma unroll
            for (int ai = 0; ai < 2; ++ai) if (ai < nai) {
                f32x4 cu[4], bz[4];
#pragma unroll
                for (int m = 0; m < 4; ++m) { const f32x4 b = acc[ai][0][m][0], c = acc[ai][0][m][1], uu = acc[ai][1][m][0], z = acc[ai][1][m][1]; cu[m] = c * uu; bz[m] = b * silu4(z); }
                const int grow = u.row0 + ai * HALF + wr * 64, g64 = grow >> 6;
#pragma unroll
                for (int m = 0; m < 4; ++m) {
                    const int row = grow + m * 16 + fr;
                    if (row < MP) { const int t = row & (PT - 1); if (t >= PT - 2) *(f32x4*)(dout + OO_PSTATE + (size_t)((row >> 13) * 2 + (t - (PT - 2))) * CD + ch0) = cu[m]; }
                    else { const int ms = row - MP, t = ms & (ST - 1); if (t >= ST - 2) *(f32x4*)(dout + OO_SSTATE + (size_t)((ms >> 6) * 2 + (t - (ST - 2))) * CD + ch0) = cu[m]; }
                    const f32x4 pv = cu[m > 0 ? m - 1 : 0]; f32x4 a1, a2;
#pragma unroll
                    for (int e = 0; e < 4; ++e) { const float r1c = DPP_ROR(cu[m][e], 1), r1p = DPP_ROR(pv[e], 1), r2c = DPP_ROR(cu[m][e], 2), r2p = DPP_ROR(pv[e], 2);
                        a1[e] = fr >= 1 ? r1c : r1p; a2[e] = fr >= 2 ? r2c : r2p; }
                    const f32x4 o = bz[m] * (w0 * a2 + w1 * a1 + w2 * cu[m]);
                    if (m > 0 || fr >= 2) *(u32x2*)(MIXo + ktm(row, ch0, MT)) = pk4(o);
                    else { *(f32x4*)(FCU + ((size_t)g64 * 2 + fr) * CD + ch0) = cu[0]; *(f32x4*)(FBZ + ((size_t)g64 * 2 + fr) * CD + ch0) = bz[0]; }
                    if (m == 3 && fr >= 14) *(f32x4*)(LCU + ((size_t)g64 * 2 + (fr - 14)) * CD + ch0) = cu[3];
                }
            }
#undef DPP_ROR
        } else if (u.pn < 28) {
            const bool isz = u.pn >= 26; bf16_t* O = isz ? SZMo : QMo; const int col0 = ((u.pn - 24) & 1) * 256 + wc * 32 + fq * 8;
#pragma unroll
            for (int ai = 0; ai < 2; ++ai) if (ai < nai)
#pragma unroll
                for (int m = 0; m < 4; ++m) { bf16_t* rowp = O + ((size_t)u.row0 + ai * HALF + wr * 64 + m * 16 + fr) * MD + col0;
#pragma unroll
                    for (int bj = 0; bj < 2; ++bj) { f32x4 v0 = acc[ai][bj][m][0], v1 = acc[ai][bj][m][1]; if (isz) { v0 = silu4(v0); v1 = silu4(v1); }
                        *(u32x4*)(rowp + bj * HALF) = pk8(v0, v1); } }
        } else {
            const int e = u.pn - 28, layer = e >> 2, ct = e & 3; const bool isv = ct >= 2; const int col0 = (ct & 1) * 256 + wc * 32 + fq * 8;
            float* fo = dout + (isv ? OO_PMEMV : OO_PMEMK) + (size_t)layer * PB * NMEM * MD; bf16_t* ho = (isv ? MEMVo : MEMKo) + (size_t)layer * NMB * NMEM * MD;
#pragma unroll
            for (int ai = 0; ai < 2; ++ai) if (ai < nai)
#pragma unroll
                for (int m = 0; m < 4; ++m) { const size_t ro = (size_t)(u.row0 - MT + ai * HALF + wr * 64 + m * 16 + fr) * MD + col0;
#pragma unroll
                    for (int bj = 0; bj < 2; ++bj) { const f32x4 v0 = acc[ai][bj][m][0], v1 = acc[ai][bj][m][1];
                        *(f32x4*)(fo + ro + bj * HALF) = v0; *(f32x4*)(fo + ro + bj * HALF + 4) = v1; *(u32x4*)(ho + ro + bj * HALF) = pk8(v0, v1); } }
        }
    }
};
struct EpiD {
    static constexpr bool PERM = false, AFTER_DRAIN = false;
    bf16_t* O;
    __device__ __forceinline__ void operator()(const f32x4 (&acc)[2][2][4][2], const Unit& u, int wr, int wc, int fr, int fq) const {
        const int col0 = u.pn * BM + wc * 32 + fq * 8; const int nai = u.half ? 1 : 2;
#pragma unroll
        for (int ai = 0; ai < 2; ++ai) if (ai < nai)
#pragma unroll
            for (int m = 0; m < 4; ++m) { bf16_t* rowp = O + ((size_t)u.row0 + ai * HALF + wr * 64 + m * 16 + fr) * DM + col0;
#pragma unroll
                for (int bj = 0; bj < 2; ++bj) *(u32x4*)(rowp + bj * HALF) = pk8(acc[ai][bj][m][0], acc[ai][bj][m][1]); }
    }
};
struct EpiX1 {
    static constexpr bool PERM = false, AFTER_DRAIN = false;
    const bf16_t* XN0; int xn0_rows; const float* RS0; bf16_t* XU; float* SS1;
    __device__ __forceinline__ void operator()(const f32x4 (&acc)[2][2][4][2], const Unit& u, int wr, int wc, int fr, int fq) const {
        const int col0 = u.pn * BM + wc * 32 + fq * 8; const int nai = u.half ? 1 : 2;
#pragma unroll
        for (int ai = 0; ai < 2; ++ai) if (ai < nai) {
            u32x4 xw[4][2]; float ir[4];
#pragma unroll
            for (int m = 0; m < 4; ++m) { const int row = u.row0 + ai * HALF + wr * 64 + m * 16 + fr; ir[m] = RS0[row];
#pragma unroll
                for (int bj = 0; bj < 2; ++bj) xw[m][bj] = *(const u32x4*)(XN0 + ktm(row, col0 + bj * HALF, xn0_rows)); }
#pragma unroll
            for (int m = 0; m < 4; ++m) { const int row = u.row0 + ai * HALF + wr * 64 + m * 16 + fr; const float r_ = 1.0f / ir[m]; float ss = 0.f;
#pragma unroll
                for (int bj = 0; bj < 2; ++bj) { const u32x4 w = xw[m][bj];
                    const f32x4 a = (f32x4){__uint_as_float(w.x << 16), __uint_as_float(w.x & 0xffff0000u), __uint_as_float(w.y << 16), __uint_as_float(w.y & 0xffff0000u)} * r_ + acc[ai][bj][m][0];
                    const f32x4 b = (f32x4){__uint_as_float(w.z << 16), __uint_as_float(w.z & 0xffff0000u), __uint_as_float(w.w << 16), __uint_as_float(w.w & 0xffff0000u)} * r_ + acc[ai][bj][m][1];
                    ss += ((a[0] * a[0] + a[1] * a[1]) + (a[2] * a[2] + a[3] * a[3])) + ((b[0] * b[0] + b[1] * b[1]) + (b[2] * b[2] + b[3] * b[3]));
                    *(u32x4*)(XU + ktm(row, col0 + bj * HALF, MT)) = pk8(a, b); }
                ss += __shfl_xor(ss, 16); ss += __shfl_xor(ss, 32);
                if (fq == 0) atomicAdd(SS1 + row, ss); }
        }
    }
};
struct EpiB {
    static constexpr bool PERM = false, AFTER_DRAIN = false;
    unsigned char* wsb; float* dout;
    float* kn2;
    const float* ss1;
    __device__ __forceinline__ void operator()(const f32x4 (&acc)[2][2][4][2], const Unit& u, int wr, int wc, int fr, int fq) const {
        const int cin = wc * 32 + fq * 8; const int nai = u.half ? 1 : 2;
        float rsv[2][4];
#pragma unroll
        for (int ai = 0; ai < 2; ++ai)
#pragma unroll
            for (int m = 0; m < 4; ++m) rsv[ai][m] = ai < nai ? ss1[u.row0 + ai * HALF + wr * 64 + m * 16 + fr] : 0.f;
#pragma unroll
        for (int ai = 0; ai < 2; ++ai)
#pragma unroll
            for (int m = 0; m < 4; ++m) rsv[ai][m] = 1.0f / sqrtf(rsv[ai][m] * (1.0f / DM) + EPS);
        if (u.pn < 12) {
            const bool isv = u.pn >= 6; const int col0 = (u.pn - (isv ? 6 : 0)) * BM + cin; const bool pr = u.row0 < MP;
            float* fo = pr ? dout + (isv ? OO_PV : OO_PK) : dout + (isv ? OO_SV : OO_SK) - (size_t)MP * CD; bf16_t* ho = (bf16_t*)(wsb + (isv ? WS_VB : WS_KB));
#pragma unroll
            for (int ai = 0; ai < 2; ++ai) if (ai < nai)
#pragma unroll
                for (int m = 0; m < 4; ++m) { const int row_ = u.row0 + ai * HALF + wr * 64 + m * 16 + fr; const size_t ro = (size_t)row_ * CD + col0; const float rs = rsv[ai][m];
#pragma unroll
                    for (int bj = 0; bj < 2; ++bj) { const f32x4 v0 = acc[ai][bj][m][0] * rs, v1 = acc[ai][bj][m][1] * rs;
                        *(f32x4*)(fo + ro + bj * HALF) = v0; *(f32x4*)(fo + ro + bj * HALF + 4) = v1; if (pr) *(u32x4*)(ho + ro + bj * HALF) = pk8(v0, v1); } }
            if (pr && !isv) {
#pragma unroll
                for (int ai = 0; ai < 2; ++ai) if (ai < nai)
#pragma unroll
                    for (int bj = 0; bj < 2; ++bj)
#pragma unroll
                        for (int m = 0; m < 4; ++m) { const int row = u.row0 + ai * HALF + wr * 64 + m * 16 + fr, head = u.pn * 2 + bj; const float rs = rsv[ai][m];
                            const f32x4 a = acc[ai][bj][m][0] * rs, b = acc[ai][bj][m][1] * rs;
                            float ss = ((a[0] * a[0] + a[1] * a[1]) + (a[2] * a[2] + a[3] * a[3])) + ((b[0] * b[0] + b[1] * b[1]) + (b[2] * b[2] + b[3] * b[3]));
                            ss += __shfl_xor(ss, 16); ss += __shfl_xor(ss, 32);
                            if (fq == 0) atomicAdd(kn2 + (size_t)((row >> 13) * NHF + head) * PT + (row & (PT - 1)), ss); }
            }
        } else {
            size_t ob; int ld, col0; bool act;
            if (u.pn < 18) { ob = WS_QF; ld = CD; col0 = (u.pn - 12) * BM; act = false; } else if (u.pn < 24) { ob = WS_SZF; ld = CD; col0 = (u.pn - 18) * BM; act = true; }
            else if (u.pn < 26) { ob = WS_QM; ld = MD; col0 = (u.pn - 24) * BM; act = false; } else { ob = WS_SZM; ld = MD; col0 = (u.pn - 26) * BM; act = true; }
            bf16_t* O = (bf16_t*)(wsb + ob); col0 += cin;
#pragma unroll
            for (int ai = 0; ai < 2; ++ai) if (ai < nai)
#pragma unroll
                for (int m = 0; m < 4; ++m) { const int row_ = u.row0 + ai * HALF + wr * 64 + m * 16 + fr; bf16_t* rowp = O + (size_t)row_ * ld + col0; const float rs = rsv[ai][m];
#pragma unroll
                    for (int bj = 0; bj < 2; ++bj) { f32x4 v0 = acc[ai][bj][m][0] * rs, v1 = acc[ai][bj][m][1] * rs; if (act) { v0 = silu4(v0); v1 = silu4(v1); }
                        *(u32x4*)(rowp + bj * HALF) = pk8(v0, v1); } }
        }
    }
};
template <class Epi, class Sched, bool ALIGN_EPI = false, bool SP2 = false>
__device__ __forceinline__ void gemm_phase(PG8_LAS unsigned char* lds, const Gemm g, const Sched& S, const Epi& E) {
    int tid_ = threadIdx.x; asm volatile("" : "+v"(tid_));
    const int tid = tid_, wid = __builtin_amdgcn_readfirstlane(tid >> 6), lane = tid & 63, wr = wid >> 2, wc = wid & 3, fr = lane & 15, fq = lane >> 4;
    const int K = BK, nt = g.K / BK;
    unsigned voffA[2], voffB[2];
#pragma unroll
    for (int i = 0; i < 2; ++i) { int R, C; stage_rc(tid * 16 + i * 8192, R, C); const int Rb = Epi::PERM ? ((R & ~31) + perm32(R & 31)) : R;
        voffA[i] = (unsigned)(R * K + C) * 2u; voffB[i] = (unsigned)(Rb * K + C) * 2u; }
    const size_t kstepA = (size_t)g.rowsA * (BK * 2), kstepB = (size_t)g.rowsB * (BK * 2);
    const size_t hstep = (size_t)HALF * K * 2;
    const size_t tstep = 2 * hstep;
    const unsigned ldsw = (unsigned)wid * 1024u;
    const int aoff = lds_byte(wr * 64 + fr, fq * 8), boff = lds_byte(wc * 32 + fr, fq * 8);
#define PG8_SA(b, h) (((b) * 2 + (h)) * HTB)
#define PG8_SB(b, h) ((4 + (b) * 2 + (h)) * HTB)
#define PG8_STAGE(bufoff, gbase, voff) do { _Pragma("unroll") for (int _i = 0; _i < 2; ++_i) \
        __builtin_amdgcn_global_load_lds((const unsigned*)((const char*)(gbase) + (voff)[_i]), (PG8_LAS unsigned*)(lds + (bufoff) + ldsw + _i * 8192), 16, 0, 0); } while (0)
#define PG8_LDA(dst, b, h) do { _Pragma("unroll") for (int m = 0; m < 4; ++m) _Pragma("unroll") for (int k = 0; k < 2; ++k) dst[m][k] = *(const PG8_LAS bf16x8*)(lds + PG8_SA(b, h) + aoff + m * 2048 + k * 1024); } while (0)
#define PG8_LDB(dst, b, h) do { _Pragma("unroll") for (int n = 0; n < 2; ++n) _Pragma("unroll") for (int k = 0; k < 2; ++k) dst[n][k] = *(const PG8_LAS bf16x8*)(lds + PG8_SB(b, h) + boff + n * 2048 + k * 1024); } while (0)
#define PG8_MMA(ai, bj, At, Bt) do { __builtin_amdgcn_s_setprio(1); _Pragma("unroll") for (int m = 0; m < 4; ++m) _Pragma("unroll") for (int n = 0; n < 2; ++n) _Pragma("unroll") for (int k = 0; k < 2; ++k) \
        acc[ai][bj][m][n] = __builtin_amdgcn_mfma_f32_16x16x32_bf16(Bt[n][k], At[m][k], acc[ai][bj][m][n], 0, 0, 0); __builtin_amdgcn_s_setprio(0); } while (0)
#define PG8_WAIT_V(n) asm volatile("s_waitcnt vmcnt(" #n ")" ::: "memory")
#define PG8_WAIT_L(n) asm volatile("s_waitcnt lgkmcnt(" #n ")" ::: "memory")
#define PG8_BAR __builtin_amdgcn_s_barrier()
#define PG8_SCHED __builtin_amdgcn_sched_barrier(0)
    Unit cur, nxt; int ui = 0;
    if (!S.next(0, cur)) return;
    f32x4 acc[2][2][4][2];
#pragma unroll
    for (int a = 0; a < 2; ++a)
#pragma unroll
        for (int b = 0; b < 2; ++b)
#pragma unroll
            for (int m = 0; m < 4; ++m)
#pragma unroll
                for (int n = 0; n < 2; ++n) acc[a][b][m][n] = (f32x4){0.f, 0.f, 0.f, 0.f};
    bf16x8 At[4][2], B0[2][2], B1[2][2];
    const size_t rstep = (size_t)K * 2;
    const char* cA = (const char*)g.A + (size_t)cur.row0 * rstep; const char* cB = (const char*)g.Bt + (size_t)cur.pn * tstep; size_t cH = cur.half ? (size_t)0 : hstep;
    S.a_ready(cur);
    if constexpr (SP2) {
        PG8_STAGE(PG8_SB(0, 0), cB, voffB); PG8_STAGE(PG8_SB(0, 1), cB + hstep, voffB); PG8_STAGE(PG8_SA(0, 0), cA, voffA); PG8_STAGE(PG8_SA(0, 1), cA + cH, voffA);
        if (wr == 1) PG8_BAR;
        PG8_WAIT_V(2); PG8_BAR;
        PG8_STAGE(PG8_SB(1, 0), cB + kstepB, voffB); PG8_STAGE(PG8_SA(1, 0), cA + kstepA, voffA); PG8_STAGE(PG8_SB(1, 1), cB + hstep + kstepB, voffB);
        PG8_WAIT_V(6); PG8_BAR;
    } else {
        PG8_STAGE(PG8_SB(0, 0), cB, voffB); PG8_STAGE(PG8_SA(0, 0), cA, voffA); PG8_STAGE(PG8_SB(0, 1), cB + hstep, voffB); PG8_STAGE(PG8_SA(0, 1), cA + cH, voffA);
        if (wr == 1) PG8_BAR;
        PG8_WAIT_V(4); PG8_BAR;
        PG8_STAGE(PG8_SB(1, 0), cB + kstepB, voffB); PG8_STAGE(PG8_SA(1, 0), cA + kstepA, voffA); PG8_STAGE(PG8_SB(1, 1), cB + hstep + kstepB, voffB);
        PG8_WAIT_V(6); PG8_BAR;
    }
    for (;;) {
        const bool has_next = S.next(ui + 1, nxt);
        const char* nA = has_next ? (const char*)g.A + (size_t)nxt.row0 * rstep : cA; const char* nB = has_next ? (const char*)g.Bt + (size_t)nxt.pn * tstep : cB; const size_t nH = has_next ? (nxt.half ? (size_t)0 : hstep) : cH;
        for (int t = 0; t < nt; t += 2) {
            const bool last = (t == nt - 2);
            const char* a1 = cA + (size_t)(t + 1) * kstepA;
            const char* a2 = last ? nA : cA + (size_t)(t + 2) * kstepA; const char* b2 = last ? nB : cB + (size_t)(t + 2) * kstepB;
            const char* a3 = a2 + kstepA; const char* b3 = b2 + kstepB; const char* a2h = a2 + (last ? nH : cH);
            if (last && has_next) S.a_ready(nxt);
            if constexpr (SP2) {
            PG8_LDB(B0, 0, 0); PG8_LDB(B1, 0, 1); PG8_SCHED; PG8_LDA(At, 0, 0); PG8_STAGE(PG8_SA(1, 1), a1 + cH, voffA);
            PG8_WAIT_V(8); PG8_WAIT_L(0); PG8_BAR; PG8_MMA(0, 0, At, B0); PG8_MMA(0, 1, At, B1); PG8_BAR; PG8_SCHED;
            if (!cur.half) PG8_LDA(At, 0, 1); PG8_STAGE(PG8_SB(0, 0), b2, voffB); PG8_STAGE(PG8_SB(0, 1), b2 + hstep, voffB); PG8_STAGE(PG8_SA(0, 0), a2, voffA);
            PG8_WAIT_V(8); PG8_WAIT_L(0); PG8_BAR; if (!cur.half) { PG8_MMA(1, 0, At, B0); PG8_MMA(1, 1, At, B1); } PG8_BAR; PG8_SCHED;
            PG8_LDB(B0, 1, 0); PG8_LDB(B1, 1, 1); PG8_SCHED; PG8_LDA(At, 1, 0); PG8_STAGE(PG8_SA(0, 1), a2h, voffA);
            PG8_WAIT_V(8); PG8_WAIT_L(0); PG8_BAR; PG8_MMA(0, 0, At, B0); PG8_MMA(0, 1, At, B1); PG8_BAR; PG8_SCHED;
            if (!cur.half) PG8_LDA(At, 1, 1); PG8_STAGE(PG8_SB(1, 0), b3, voffB); PG8_STAGE(PG8_SB(1, 1), b3 + hstep, voffB); PG8_STAGE(PG8_SA(1, 0), a3, voffA);
            PG8_WAIT_V(8); PG8_WAIT_L(0); PG8_BAR; if (!cur.half) { PG8_MMA(1, 0, At, B0); PG8_MMA(1, 1, At, B1); } PG8_BAR; PG8_SCHED;
            } else {
            PG8_LDB(B0, 0, 0); PG8_SCHED; PG8_LDA(At, 0, 0); PG8_STAGE(PG8_SA(1, 1), a1 + cH, voffA);
            PG8_WAIT_L(8); PG8_BAR; PG8_WAIT_L(0); PG8_MMA(0, 0, At, B0); PG8_BAR; PG8_SCHED;
            PG8_LDB(B1, 0, 1); PG8_STAGE(PG8_SB(0, 0), b2, voffB);
            PG8_BAR; PG8_WAIT_L(0); PG8_MMA(0, 1, At, B1); PG8_BAR;
            PG8_LDA(At, 0, 1); PG8_STAGE(PG8_SA(0, 0), a2, voffA);
            PG8_BAR; PG8_WAIT_L(0); PG8_MMA(1, 0, At, B0); PG8_BAR; PG8_SCHED;
            PG8_STAGE(PG8_SB(0, 1), b2 + hstep, voffB);
            PG8_WAIT_V(6); PG8_BAR; PG8_MMA(1, 1, At, B1); PG8_BAR;
            PG8_LDB(B0, 1, 0); PG8_SCHED; PG8_LDA(At, 1, 0); PG8_STAGE(PG8_SA(0, 1), a2h, voffA);
            PG8_WAIT_L(8); PG8_BAR; PG8_WAIT_L(0); PG8_MMA(0, 0, At, B0); PG8_BAR; PG8_SCHED;
            PG8_LDB(B1, 1, 1); PG8_STAGE(PG8_SB(1, 0), b3, voffB);
            PG8_BAR; PG8_WAIT_L(0); PG8_MMA(0, 1, At, B1); PG8_BAR;
            PG8_LDA(At, 1, 1); PG8_STAGE(PG8_SA(1, 0), a3, voffA);
            PG8_BAR; PG8_WAIT_L(0); PG8_MMA(1, 0, At, B0); PG8_BAR; PG8_SCHED;
            PG8_STAGE(PG8_SB(1, 1), b3 + hstep, voffB);
            PG8_WAIT_V(6); PG8_BAR; PG8_MMA(1, 1, At, B1); PG8_BAR;
            }
        }
        if constexpr (ALIGN_EPI) { if (wr == 0) PG8_BAR; }
        if constexpr (!Epi::AFTER_DRAIN) { E(acc, cur, wr, wc, fr, fq); S.done(cur); }
        if (!has_next) break;
#pragma unroll
        for (int a = 0; a < 2; ++a)
#pragma unroll
            for (int b = 0; b < 2; ++b)
#pragma unroll
                for (int m = 0; m < 4; ++m)
#pragma unroll
                    for (int n = 0; n < 2; ++n) acc[a][b][m][n] = (f32x4){0.f, 0.f, 0.f, 0.f};
        cur = nxt; cA = nA; cB = nB; cH = nH; ++ui;
        if constexpr (ALIGN_EPI) { if (wr == 1) PG8_BAR; }
    }
    PG8_WAIT_V(0);
    if constexpr (!ALIGN_EPI) { if (wr == 0) PG8_BAR; }
    PG8_BAR;
    if constexpr (Epi::AFTER_DRAIN) { E.fused(acc, cur, wr, wc, fr, fq, lds, wid, lane); S.done(cur); }
#undef PG8_SA
#undef PG8_SB
#undef PG8_STAGE
#undef PG8_LDA
#undef PG8_LDB
#undef PG8_MMA
#undef PG8_WAIT_V
#undef PG8_WAIT_L
#undef PG8_BAR
#undef PG8_SCHED
}
}
namespace fa {
typedef unsigned short bf16_t;
typedef short bf16x8 __attribute__((ext_vector_type(8)));
typedef short s16x4 __attribute__((ext_vector_type(4)));
typedef float f32x16 __attribute__((ext_vector_type(16)));
typedef float f32x4 __attribute__((ext_vector_type(4)));
typedef unsigned u32x4 __attribute__((ext_vector_type(4)));
template <class A, class Bt> struct same_t { static constexpr bool v = false; };
template <class A> struct same_t<A, A> { static constexpr bool v = true; };
constexpr float SCALE = 0.08838834764831845f;
constexpr float THR = 40.f;
constexpr int D = 128, NW = 8, QBLK = 32, KVBLK = 64, QB = NW * QBLK;
constexpr int SHM_V = KVBLK * D * 2, SHM_K = KVBLK * D * 2;
constexpr int LDS_WS = 2 * SHM_V + 2 * SHM_K;
constexpr int LDS_BIAS = LDS_WS + NW * 64 * 4;
constexpr int BIAS_KEYS = 8192;
constexpr int LDS_FLAGS = LDS_BIAS + BIAS_KEYS * 4;
constexpr int LDS_QSLOT = LDS_FLAGS + 32;
constexpr int LDS_KINF = LDS_FLAGS + 64;
constexpr int LDS_BYTES = LDS_KINF + 512;
constexpr float DELTA_RAW = 32.0f / 0.08838834764831845f;
constexpr unsigned WINF = 0x40000000u;

#define KSWZ(row, colB) ((row) * 256 + ((colB) ^ (((row) & 7) << 4)))
#define SBAR() __builtin_amdgcn_sched_barrier(0)
__device__ __forceinline__ int v_st(int k, int c) { const int kk = (k & ~0xC) | ((k & 4) << 1) | ((k & 8) >> 1); return ((kk >> 3) * 4 + (c >> 5)) * 512 + ((kk & 7) * 32 + (c & 31)) * 2; }
__device__ __forceinline__ int v_rd_base(int lane) { return ((lane & 3) << 3) | (((lane >> 2) & 3) << 6) | (((lane >> 4) & 1) << 5) | (((lane >> 5) & 1) << 8); }
constexpr int v_rd_off(int d0, int ks, int half) { return d0 * 512 + ks * 4096 + half * 2048; }
__device__ __forceinline__ int crow(int r, int hi) { return (r & 3) + 8 * (r >> 2) + 4 * hi; }
__device__ __forceinline__ unsigned cvtpk(float lo, float hi) { unsigned r; asm volatile("v_cvt_pk_bf16_f32 %0, %1, %2" : "=v"(r) : "v"(lo), "v"(hi)); return r; }
__device__ __forceinline__ bf16x8 pack8(f32x4 a, f32x4 b) { u32x4 w = {cvtpk(a[0], a[1]), cvtpk(a[2], a[3]), cvtpk(b[0], b[1]), cvtpk(b[2], b[3])}; return *reinterpret_cast<bf16x8*>(&w); }
__device__ __forceinline__ bf16x8 ld8h(const bf16_t* p) { return *reinterpret_cast<const bf16x8*>(p); }
__device__ __forceinline__ void mask_tile(f32x16& p0, f32x16& p1, int dq, unsigned W) {
    const float NEG = -__builtin_inff();
#pragma unroll
    for (int r = 0; r < 16; ++r) { const int c = (r & 3) + 8 * (r >> 2);
        if ((unsigned)(dq - c) >= W) p0[r] = NEG;
        if ((unsigned)(dq - c - 32) >= W) p1[r] = NEG; }
}
__device__ __forceinline__ bool partialSM(f32x16& p0, f32x16& p1, float& m_reg, float& mn, float& alpha) {
    float pmax = p0[0]; for (int r = 1; r < 16; ++r) pmax = fmaxf(pmax, p0[r]); for (int r = 0; r < 16; ++r) pmax = fmaxf(pmax, p1[r]);
    { auto rr = __builtin_amdgcn_permlane32_swap(__float_as_uint(pmax), __float_as_uint(pmax), false, false);
      pmax = fmaxf(__uint_as_float(rr[0]), __uint_as_float(rr[1])); }
    if (__all(pmax <= m_reg - DELTA_RAW)) { mn = m_reg; alpha = 1.f; return false; }
    constexpr float C2 = 1.4426950408889634f * SCALE;
    if (__builtin_expect(__all((pmax - m_reg) * SCALE <= THR), 1)) { mn = m_reg; alpha = 1.f; }
    else { mn = fmaxf(m_reg, pmax); alpha = __builtin_amdgcn_exp2f((m_reg - mn) * C2); m_reg = mn; }
    const float mnL = -mn * C2;
    for (int r = 0; r < 16; ++r) p0[r] = fmaf(p0[r], C2, mnL); for (int r = 0; r < 16; ++r) p1[r] = fmaf(p1[r], C2, mnL);
    for (int r = 0; r < 16; ++r) p0[r] = __builtin_amdgcn_exp2f(p0[r]);
    return true;
}
__device__ __forceinline__ void finishSM(f32x16& p0, f32x16& p1, float alpha, float& l_reg, bf16x8& pa0, bf16x8& pa1, bf16x8& pa2, bf16x8& pa3) {
    for (int r = 0; r < 16; ++r) p1[r] = __builtin_amdgcn_exp2f(p1[r]);
    float ps = 0; for (int r = 0; r < 16; ++r) ps += p0[r]; for (int r = 0; r < 16; ++r) ps += p1[r];
    { auto rr = __builtin_amdgcn_permlane32_swap(__float_as_uint(ps), __float_as_uint(ps), false, false);
      ps = __uint_as_float(rr[0]) + __uint_as_float(rr[1]); }
    l_reg = l_reg * alpha + ps;
#define PK4(P, B_, OUT) do { unsigned a0 = cvtpk(P[B_+0], P[B_+1]), a1 = cvtpk(P[B_+2], P[B_+3]);                          \
        unsigned b0 = cvtpk(P[B_+4], P[B_+5]), b1 = cvtpk(P[B_+6], P[B_+7]);                                             \
        auto r0 = __builtin_amdgcn_permlane32_swap(a0, b0, false, false); auto r1 = __builtin_amdgcn_permlane32_swap(a1, b1, false, false); \
        u32x4 w = {r0[0], r1[0], r0[1], r1[1]}; OUT = *reinterpret_cast<bf16x8*>(&w); } while (0)
    PK4(p0, 0, pa0); PK4(p0, 8, pa1); PK4(p1, 0, pa2); PK4(p1, 8, pa3);
#undef PK4
}
template <int KB>
__device__ __forceinline__ void qkt(f32x16& p0, f32x16& p1, const char* K_lds, const char* bl, int r32, int hi, const bf16x8* qr) {
#pragma unroll
    for (int j = 0; j < 4; ++j) { const f32x4 a = *reinterpret_cast<const f32x4*>(bl + 32 * j), b = *reinterpret_cast<const f32x4*>(bl + 128 + 32 * j);
        p0[4 * j] = a[0]; p0[4 * j + 1] = a[1]; p0[4 * j + 2] = a[2]; p0[4 * j + 3] = a[3]; p1[4 * j] = b[0]; p1[4 * j + 1] = b[1]; p1[4 * j + 2] = b[2]; p1[4 * j + 3] = b[3]; }
    const char* kb[4];
#pragma unroll
    for (int dd = 0; dd < 4; ++dd) kb[dd] = K_lds + KB * SHM_K + KSWZ(r32, (dd * 16 + hi * 8) * 2);
#pragma unroll
    for (int d0 = 0; d0 < 8; ++d0) { const char* a = kb[d0 & 3] + (d0 >> 2) * 128;
        bf16x8 b0 = *reinterpret_cast<const bf16x8*>(a);
        bf16x8 b1 = *reinterpret_cast<const bf16x8*>(a + 32 * 256);
        p0 = __builtin_amdgcn_mfma_f32_32x32x16_bf16(b0, qr[d0], p0, 0, 0, 0);
        p1 = __builtin_amdgcn_mfma_f32_32x32x16_bf16(b1, qr[d0], p1, 0, 0, 0); }
}
template <int VB>
__device__ __forceinline__ void pv_tile(f32x16* o, int vb0, bf16x8 pa0, bf16x8 pa1, bf16x8 pa2, bf16x8 pa3) {
#define TRRD(dst, off) asm volatile("ds_read_b64_tr_b16 %0, %1 offset:%2" : "=&v"(dst) : "v"(vb0), "i"(off) : "memory")
#define PV_D0(d0) do { s16x4 l0, l1, l2, l3, h0, h1, h2, h3; constexpr int b_ = VB * SHM_V + v_rd_off(d0, 0, 0);     \
        TRRD(l0, b_); TRRD(h0, b_ + 2048); TRRD(l1, b_ + 4096); TRRD(h1, b_ + 6144); TRRD(l2, b_ + 8192); TRRD(h2, b_ + 10240); TRRD(l3, b_ + 12288); TRRD(h3, b_ + 14336); \
        asm volatile("s_waitcnt lgkmcnt(0)" ::: "memory"); SBAR();                 \
        o[d0] = __builtin_amdgcn_mfma_f32_32x32x16_bf16(pa0, (bf16x8){l0[0], l0[1], l0[2], l0[3], h0[0], h0[1], h0[2], h0[3]}, o[d0], 0, 0, 0);   \
        o[d0] = __builtin_amdgcn_mfma_f32_32x32x16_bf16(pa1, (bf16x8){l1[0], l1[1], l1[2], l1[3], h1[0], h1[1], h1[2], h1[3]}, o[d0], 0, 0, 0);   \
        o[d0] = __builtin_amdgcn_mfma_f32_32x32x16_bf16(pa2, (bf16x8){l2[0], l2[1], l2[2], l2[3], h2[0], h2[1], h2[2], h2[3]}, o[d0], 0, 0, 0);   \
        o[d0] = __builtin_amdgcn_mfma_f32_32x32x16_bf16(pa3, (bf16x8){l3[0], l3[1], l3[2], l3[3], h3[0], h3[1], h3[2], h3[3]}, o[d0], 0, 0, 0); } while (0)
    PV_D0(0); PV_D0(1); PV_D0(2); PV_D0(3);
#undef PV_D0
#undef TRRD
}

template <class TKV> struct BlockRef { const bf16_t* Q; const TKV* K; const TKV* V; const TKV* K2; const TKV* V2; bf16_t* O; const bf16_t* G; const float* bias; const float* kmax; int P0, skv, nvalid, ldq, ldk, ldg; };
template <class TKV> __device__ __forceinline__ int n_tiles(const BlockRef<TKV>& b) { int j = (b.P0 + QB - 1) / KVBLK + 1; const int m = b.skv / KVBLK; return j > m ? m : j; }
struct NoQueue { __device__ __forceinline__ int issue(int) const { return 0; } __device__ __forceinline__ void publish(int, int, char*) const {} };
struct AtomQueue { unsigned* ctr;
    __device__ __forceinline__ int issue(int tid) const { int v = 0; if (tid == 0) v = (int)__hip_atomic_fetch_add(ctr, 1u, __ATOMIC_RELAXED, __HIP_MEMORY_SCOPE_AGENT); return v; }
    __device__ __forceinline__ void publish(int v, int tid, char* lds) const { if (tid == 0) *(volatile int*)(lds + LDS_QSLOT) = v; } };
struct Geom { int ldo, ksplit; size_t sdo; };
template <class T> __device__ __forceinline__ const T* rowp(const T* base, int k0, int ldk, unsigned lane_elem_off) { return (const T*)((const char*)(base + (size_t)k0 * ldk) + lane_elem_off * (unsigned)sizeof(T)); }
template <class TKV> struct Seam { bf16x8 qr[8]; bf16x8 st_v0, st_v1, st_k0, st_k1; f32x4 sf0, sf1, sf2, sf3, sg0, sg1, sg2, sg3; };

#define ROW(p, k0, rr) rowp(p, k0, ldk_, (unsigned)((rr) * ldk_ + sc))
#define KSEL(B_, k0) (((k0) >= g.ksplit) ? (B_).K2 : (B_).K)
#define VSEL(B_, k0) (((k0) >= g.ksplit) ? (B_).V2 : (B_).V)
#define VMW() asm volatile("s_waitcnt vmcnt(0)" ::: "memory")
#define VMWN(n) asm volatile("s_waitcnt vmcnt(%0)" :: "i"(n) : "memory")
#define SLOAD_H(Kp, Vp, k0) do { S.st_v0 = ld8h((const bf16_t*)ROW(Vp, k0, sr)); S.st_v1 = ld8h((const bf16_t*)ROW(Vp, k0, 32 + sr));              \
                         S.st_k0 = ld8h((const bf16_t*)ROW(Kp, k0, sr)); S.st_k1 = ld8h((const bf16_t*)ROW(Kp, k0, 32 + sr)); } while (0)
#define SWRITE_HK(bf) do { *(bf16x8*)(K_lds + (bf) * SHM_K + kws) = S.st_k0; *(bf16x8*)(K_lds + (bf) * SHM_K + kws + 32 * 256) = S.st_k1; } while (0)
#define SWRITE_HV(bf) do { *(bf16x8*)(V_lds + (bf) * SHM_V + vst0) = S.st_v0; *(bf16x8*)(V_lds + (bf) * SHM_V + vst1) = S.st_v1; } while (0)
#define SWRITE_H(bf) do { SWRITE_HV(bf); SWRITE_HK(bf); } while (0)
#define SLOAD_F(p, k0) do { S.sf0 = *(const f32x4*)ROW(p, k0, sr); S.sf1 = *(const f32x4*)(ROW(p, k0, sr) + 4);                \
                            S.sf2 = *(const f32x4*)ROW(p, k0, 32 + sr); S.sf3 = *(const f32x4*)(ROW(p, k0, 32 + sr) + 4); } while (0)
#define SWRITE_KF(bf) do { *(bf16x8*)(K_lds + (bf) * SHM_K + kws) = pack8(S.sf0, S.sf1); *(bf16x8*)(K_lds + (bf) * SHM_K + kws + 32 * 256) = pack8(S.sf2, S.sf3); } while (0)
#define SLOAD_G(p, k0) do { S.sg0 = *(const f32x4*)ROW(p, k0, sr); S.sg1 = *(const f32x4*)(ROW(p, k0, sr) + 4);                \
                            S.sg2 = *(const f32x4*)ROW(p, k0, 32 + sr); S.sg3 = *(const f32x4*)(ROW(p, k0, 32 + sr) + 4); } while (0)
#define SWRITE_VF(bf) do { *(bf16x8*)(V_lds + (bf) * SHM_V + vst0) = pack8(S.sg0, S.sg1); *(bf16x8*)(V_lds + (bf) * SHM_V + vst1) = pack8(S.sg2, S.sg3); } while (0)
#define QROWP(B_) ((B_).Q + (size_t)((wid * QBLK + r32) & ((B_).nvalid - 1)) * (B_).ldq + hi * 8)
template <class TKV>
__device__ __forceinline__ void attn_prime(const BlockRef<TKV>& cur, const Geom g, char* lds, Seam<TKV>& S) {
    constexpr bool F32 = same_t<TKV, float>::v;
    int tid_ = threadIdx.x; asm volatile("" : "+v"(tid_));
    const int tid = tid_, wid = __builtin_amdgcn_readfirstlane(tid >> 6), lane = tid & 63, r32 = lane & 31, hi = lane >> 5;
    const int sr = tid >> 4, sc = (tid & 15) * 8, kws = KSWZ(sr, sc * 2); char* K_lds = lds + 2 * SHM_V;
    { const bf16_t* qp = QROWP(cur);
#pragma unroll
      for (int d0 = 0; d0 < 8; ++d0) S.qr[d0] = ld8h(qp + d0 * 16); }
    const int kb0 = (n_tiles(cur) - 1) * KVBLK, ldk_ = cur.ldk;
    if constexpr (F32) { SLOAD_F((const float*)KSEL(cur, kb0), kb0); VMW(); SWRITE_KF(0); SBAR(); SLOAD_G((const float*)VSEL(cur, kb0), kb0); }
    else { SLOAD_H(KSEL(cur, kb0), VSEL(cur, kb0), kb0); VMW(); SWRITE_HK(0); }
    __syncthreads();
}
template <class TKV, bool SKIP, class QH>
__device__ __forceinline__ void attn_block(const BlockRef<TKV>& cur, const BlockRef<TKV>& nxt, const Geom g, char* lds, Seam<TKV>& S, const QH& qh) {
    constexpr bool F32 = same_t<TKV, float>::v;
    int tid_ = threadIdx.x; asm volatile("" : "+v"(tid_));
    const int tid = tid_, wid = __builtin_amdgcn_readfirstlane(tid >> 6), lane = tid & 63, r32 = lane & 31, hi = lane >> 5;
    const int NTT = n_tiles(cur); int NT = NTT;
    const int kbn = (n_tiles(nxt) - 1) * KVBLK; int ldk_ = cur.ldk;
    const int qlo = cur.P0 + wid * QBLK, qm = qlo + r32 - 4 * hi;
    const bool wact = !F32 || wid * QBLK < cur.nvalid;
    char* V_lds = lds; char* K_lds = lds + 2 * SHM_V;
    float* ws = (float*)(lds + LDS_WS) + wid * 64; float* li_l = ws, * al_l = ws + 32;
    const char* bl = lds + LDS_BIAS + hi * 16;
    float m_reg = -1e30f, l_reg = 0; f32x16 o[4] = {};
    const int sr = tid >> 4, sc = (tid & 15) * 8, vst0 = v_st(sr, sc), vst1 = v_st(32 + sr, sc), kws = KSWZ(sr, sc * 2);
    const int vb0 = (int)(uintptr_t)V_lds + v_rd_base(lane);
    { f32x4* bdst = (f32x4*)(lds + LDS_BIAS);
      if (cur.bias) { const f32x4* bsrc = (const f32x4*)cur.bias; f32x4 bt[4];
#pragma unroll
          for (int j = 0; j < 4; ++j) { const int i = tid + j * NW * 64; if (i < NTT * 16) bt[j] = bsrc[i]; }
#pragma unroll
          for (int j = 0; j < 4; ++j) { const int i = tid + j * NW * 64; if (i < NTT * 16) bdst[i] = bt[j]; } }
      else { f32x4 z = {0.f, 0.f, 0.f, 0.f}; asm volatile("" : "+v"(z));
             for (int i = tid; i < NTT * 16; i += NW * 64) bdst[i] = z; } }
    const bool doskip = SKIP && cur.kmax != nullptr;
    if constexpr (SKIP) { if (doskip) {
        float v = 0.f;
        if (tid < NTT * 4) { const f32x4* kp = (const f32x4*)(cur.kmax + 16 * tid); const f32x4 a = kp[0], b = kp[1], c = kp[2], d = kp[3];
            v = fmaxf(fmaxf(fmaxf(fmaxf(a[0], a[1]), fmaxf(a[2], a[3])), fmaxf(fmaxf(b[0], b[1]), fmaxf(b[2], b[3]))), fmaxf(fmaxf(fmaxf(c[0], c[1]), fmaxf(c[2], c[3])), fmaxf(fmaxf(d[0], d[1]), fmaxf(d[2], d[3])))); }
        v = fmaxf(v, __int_as_float(__builtin_amdgcn_ds_bpermute((lane ^ 1) << 2, __float_as_int(v)))); v = fmaxf(v, __int_as_float(__builtin_amdgcn_ds_bpermute((lane ^ 2) << 2, __float_as_int(v))));
        if ((tid & 3) == 0 && tid < NTT * 4) ((float*)(lds + LDS_KINF))[tid >> 2] = v;
    } }
    __syncthreads();
    if constexpr (SKIP) { if (doskip) {
        if (wid == 0) { float* kinf = (float*)(lds + LDS_KINF); float a = lane < NTT ? kinf[lane] : 0.f, b = 64 + lane < NTT ? kinf[64 + lane] : 0.f;
#pragma unroll
            for (int o = 1; o < 64; o <<= 1) { const int src = ((lane - o) & 63) << 2;
                const float na = __int_as_float(__builtin_amdgcn_ds_bpermute(src, __float_as_int(a))), nb = __int_as_float(__builtin_amdgcn_ds_bpermute(src, __float_as_int(b)));
                if (lane >= o) { a = fmaxf(a, na); b = fmaxf(b, nb); } }
            b = fmaxf(b, __int_as_float(__builtin_amdgcn_ds_bpermute((63 + 0 * lane) << 2, __float_as_int(a))));
            kinf[lane] = sqrtf(a) * 1.004f; kinf[64 + lane] = sqrtf(b) * 1.004f; }
        float qn1 = 0.f;
#pragma unroll
        for (int d0 = 0; d0 < 8; ++d0) { const u32x4 w = __builtin_bit_cast(u32x4, S.qr[d0]);
#define SQ2(x) (__uint_as_float((x) << 16) * __uint_as_float((x) << 16) + __uint_as_float((x) & 0xffff0000u) * __uint_as_float((x) & 0xffff0000u))
            qn1 += (SQ2(w.x) + SQ2(w.y)) + (SQ2(w.z) + SQ2(w.w)); }
#undef SQ2
        { auto rr = __builtin_amdgcn_permlane32_swap(__float_as_uint(qn1), __float_as_uint(qn1), false, false); qn1 = __uint_as_float(rr[0]) + __uint_as_float(rr[1]); }
        if (hi == 0) li_l[r32] = sqrtf(qn1) * 1.0001f;
    } }
    __syncthreads();
#define RESC(a) do { if (__any((a) < 1.f)) { if (hi == 0) al_l[r32] = (a); asm volatile("s_waitcnt lgkmcnt(0)" ::: "memory");              \
                     for (int d_ = 0; d_ < 4; ++d_) for (int r = 0; r < 16; ++r) o[d_][r] *= al_l[crow(r, hi)]; } } while (0)
#define KBASE(t) ((NTT - 1 - (t)) * KVBLK)
#define MASKT(P0_, P1_, t) do { const int kb_ = KBASE(t); if (kb_ + KVBLK - 1 > qlo) mask_tile(P0_, P1_, qm - kb_, WINF); } while (0)
    constexpr int NQL = 8;
#define SEAM_K0() do { VMWN(NQL); if constexpr (F32) { SWRITE_KF(0); SBAR(); SLOAD_G((const float*)VSEL(nxt, kbn), kbn); } else { SWRITE_HK(0); } SBAR(); } while (0)
    f32x16 pA0, pA1, pB0, pB1; float mnA, mnB, alA, alB; bf16x8 pa0, pa1, pa2, pa3;
    if constexpr (F32) { VMW(); SWRITE_VF(0); SBAR(); } else { SWRITE_HV(0); SBAR(); }
    if (NT > 1) { if constexpr (F32) { SLOAD_F((const float*)KSEL(cur, KBASE(1)), KBASE(1)); SBAR(); SLOAD_G((const float*)VSEL(cur, KBASE(1)), KBASE(1)); } else SLOAD_H(KSEL(cur, KBASE(1)), VSEL(cur, KBASE(1)), KBASE(1)); }
#define LIVE0(t) (wact && !(KBASE(t) > qlo + QBLK - 1))
    bool lvA = LIVE0(0), lvB = false;
    SBAR(); if (lvA) qkt<0>(pA0, pA1, K_lds, bl + KBASE(0) * 4, r32, hi, S.qr);
    if constexpr (F32) { if (NT > 1) { VMWN(4); SWRITE_KF(1); SBAR(); } }
    if (lvA) { MASKT(pA0, pA1, 0); lvA = partialSM(pA0, pA1, m_reg, mnA, alA); }
    if (NT > 1) { VMW(); if constexpr (F32) { SWRITE_VF(1); SBAR(); if (NT > 2) { SLOAD_F((const float*)KSEL(cur, KBASE(2)), KBASE(2)); SBAR(); SLOAD_G((const float*)VSEL(cur, KBASE(2)), KBASE(2)); } } else SWRITE_H(1); }
    __syncthreads();
#define HALF_STEP(PX0, PX1, mnX, alX, PY0, PY1, alY, t, KB, VB, SB, VOTE, LX, LY) do {                                                      \
        SBAR(); if constexpr (!F32) { if ((t) + 1 < NT) { SLOAD_H(KSEL(cur, KBASE((t) + 1)), VSEL(cur, KBASE((t) + 1)), KBASE((t) + 1)); } SBAR(); }     \
        LX = LIVE0(t); if (LX) qkt<KB>(PX0, PX1, K_lds, bl + KBASE(t) * 4, r32, hi, S.qr);                                   \
        if (LY) finishSM(PY0, PY1, alY, l_reg, pa0, pa1, pa2, pa3); SBAR();                                                         \
        if ((t) + 1 < NT) { if constexpr (F32) { VMWN(4); SWRITE_KF(SB); SBAR(); } }                                         \
        if (LY) pv_tile<VB>(o, vb0, pa0, pa1, pa2, pa3); if (LX) { MASKT(PX0, PX1, (t)); LX = partialSM(PX0, PX1, m_reg, mnX, alX); }   \
        __syncthreads();                                                                                                      \
        if ((t) + 1 < NT) { VMW(); if constexpr (F32) { SWRITE_VF(SB); SBAR(); if ((t) + 2 < NT) { SLOAD_F((const float*)KSEL(cur, KBASE((t) + 2)), KBASE((t) + 2)); SBAR(); SLOAD_G((const float*)VSEL(cur, KBASE((t) + 2)), KBASE((t) + 2)); } } \
                            else { SWRITE_H(SB); } }                                                                          \
        if constexpr (SKIP && (VOTE)) { if (doskip) { const int tk = NTT - 2 - (t); bool ok = true;     \
            if (tk >= 0) { const float ub = li_l[r32] * ((const float*)(lds + LDS_KINF))[tk] + ((const float*)(lds + LDS_BIAS))[64 * tk + 63]; ok = ub <= m_reg - DELTA_RAW; }              \
            const bool okw = __all(ok); if (lane == 0) ((volatile unsigned*)(lds + LDS_FLAGS))[wid] = okw ? 1u : 0u; } }                                                     \
        if (LX) { RESC(alX); } __syncthreads(); } while (0)
    for (int t = 1; t + 1 < NT; t += 2) {
        HALF_STEP(pB0, pB1, mnB, alB, pA0, pA1, alA, t, 1, 0, 0, false, lvB, lvA);
        HALF_STEP(pA0, pA1, mnA, alA, pB0, pB1, alB, t + 1, 0, 1, 1, true, lvA, lvB);
        if constexpr (SKIP) { if (doskip) { const u32x4 f0 = *(const u32x4*)(lds + LDS_FLAGS), f1 = *(const u32x4*)(lds + LDS_FLAGS + 16);
            if (__builtin_amdgcn_readfirstlane(f0.x & f0.y & f0.z & f0.w & f1.x & f1.y & f1.z & f1.w) != 0u) { NT = t + 2; break; } } }
    }
    const bool even = (NT & 1) == 0;
    if (even) { SBAR(); lvB = LIVE0(NT - 1); if (lvB) qkt<1>(pB0, pB1, K_lds, bl + KBASE(NT - 1) * 4, r32, hi, S.qr); SBAR(); }
    ldk_ = nxt.ldk;
    if constexpr (F32) { SLOAD_F((const float*)KSEL(nxt, kbn), kbn); SBAR(); } else { SLOAD_H(KSEL(nxt, kbn), VSEL(nxt, kbn), kbn); SBAR(); }
    { const bf16_t* qp = QROWP(nxt);
#pragma unroll
      for (int d0 = 0; d0 < 8; ++d0) S.qr[d0] = ld8h(qp + d0 * 16); }
    SBAR();
    if (lvA) { finishSM(pA0, pA1, alA, l_reg, pa0, pa1, pa2, pa3); SBAR();
    pv_tile<0>(o, vb0, pa0, pa1, pa2, pa3); }
    if (even) { if (lvB) { MASKT(pB0, pB1, NT - 1); lvB = partialSM(pB0, pB1, m_reg, mnB, alB); } __syncthreads(); if (lvB) { RESC(alB);
        finishSM(pB0, pB1, alB, l_reg, pa0, pa1, pa2, pa3); SBAR(); pv_tile<1>(o, vb0, pa0, pa1, pa2, pa3); } }
    SBAR(); SEAM_K0();
    const int qv = qh.issue(tid);
    if (hi == 0) li_l[r32] = l_reg; asm volatile("s_waitcnt lgkmcnt(0)" ::: "memory");
    if (wid * QBLK < cur.nvalid) {
        float rli[16];
#pragma unroll
        for (int r = 0; r < 16; ++r) rli[r] = __builtin_amdgcn_rcpf(li_l[crow(r, hi)]);
        typedef __attribute__((address_space(1))) bf16_t gbf16_t;
        gbf16_t* Ow = (gbf16_t*)(cur.O + (size_t)(wid * QBLK + 4 * hi) * g.ldo + r32); const gbf16_t* Gw = (const gbf16_t*)(cur.G + (size_t)(wid * QBLK + 4 * hi) * cur.ldg + r32);
        asm volatile("" : "+v"(Ow), "+v"(Gw));
        unsigned short gq[16][4];
#pragma unroll
        for (int r = 0; r < 16; ++r) { const int orow = (r & 3) + 8 * (r >> 2);
#pragma unroll
            for (int d0 = 0; d0 < 4; ++d0) gq[r][d0] = Gw[(size_t)orow * cur.ldg + d0 * 32]; }
        SBAR();
#pragma unroll
        for (int r = 0; r < 16; ++r) { const int orow = (r & 3) + 8 * (r >> 2);
#pragma unroll
            for (int d0 = 0; d0 < 4; ++d0) { const float v = o[d0][r] * rli[r] * __uint_as_float((unsigned)gq[r][d0] << 16); Ow[(size_t)orow * g.ldo + (size_t)(d0 >> 1) * g.sdo + (d0 & 1) * 32] = (bf16_t)(cvtpk(v, v) & 0xffffu); } }
    }
    qh.publish(qv, tid, lds);
    __syncthreads();
#undef RESC
#undef LIVE0
#undef KBASE
#undef MASKT
#undef SEAM_K0
#undef HALF_STEP
}
__device__ __forceinline__ void sample_unit(const BlockRef<float>& cur, const Geom g, char* lds) {
    int tid_ = threadIdx.x; asm volatile("" : "+v"(tid_));
    const int tid = tid_, wid = __builtin_amdgcn_readfirstlane(tid >> 6), lane = tid & 63, r32 = lane & 31, hi = lane >> 5;
    const int NTT = n_tiles(cur), NT = NTT;
    char* V_lds = lds; char* K_lds = lds + 2 * SHM_V;
    float* const kx = (float*)(lds + LDS_BIAS) + 4224;
    float* const kpart = kx; float* const kinf = kx + 256; volatile unsigned* const votes = (volatile unsigned*)(kx + 384);
    { f32x4* bdst = (f32x4*)(lds + LDS_BIAS); const f32x4* bsrc = (const f32x4*)cur.bias; f32x4 bt[4];
#pragma unroll
      for (int j = 0; j < 4; ++j) { const int i = tid + j * NW * 64; if (i < NTT * 16) bt[j] = bsrc[i]; }
#pragma unroll
      for (int j = 0; j < 4; ++j) { const int i = tid + j * NW * 64; if (i < NTT * 16) bdst[i] = bt[j]; } }
    if (tid < 4) votes[tid] = 0u;
#define KBASE(t) ((NTT - 1 - (t)) * KVBLK)
#define SU_EXIT(t) ((t) >= 1 && __builtin_amdgcn_readfirstlane(votes[(((t) - 1) & 1) * 2] & votes[(((t) - 1) & 1) * 2 + 1]) != 0u)
    const int lt = (wid & 1) * 64 + lane, key0 = lt >> 4, sc = (lt & 15) * 8; const int ldk_ = cur.ldk;
#define SU_LOADX(dst, P_, t_) do { const int kb_ = KBASE(t_); const float* Xp_ = P_(cur, kb_);                                                                                                    \
            _Pragma("unroll") for (int i = 0; i < 8; ++i) { const float* xr_ = rowp(Xp_, kb_, ldk_, (unsigned)((i * 8 + key0) * ldk_ + sc)); dst[i][0] = *(const f32x4*)xr_; dst[i][1] = *(const f32x4*)(xr_ + 4); } } while (0)
#define SU_NORM(src, t_) do { float mx_ = 0.f;                                                                                                                                                  \
            _Pragma("unroll") for (int i = 0; i < 8; ++i) { const f32x4 a_ = src[i][0], b_ = src[i][1];                                                                                          \
                float s_ = ((a_[0] * a_[0] + a_[1] * a_[1]) + (a_[2] * a_[2] + a_[3] * a_[3])) + ((b_[0] * b_[0] + b_[1] * b_[1]) + (b_[2] * b_[2] + b_[3] * b_[3]));                            \
                s_ += __shfl_xor(s_, 1); s_ += __shfl_xor(s_, 2); s_ += __shfl_xor(s_, 4); s_ += __shfl_xor(s_, 8); mx_ = fmaxf(mx_, s_); }                              \
            mx_ = fmaxf(mx_, __shfl_xor(mx_, 16)); mx_ = fmaxf(mx_, __shfl_xor(mx_, 32)); if (lane == 0) kpart[(t_) * 2 + (wid & 1)] = mx_; } while (0)
    { f32x4 xa[8][2], xb[8][2], xc[8][2]; const int ps = wid >> 1; int t0 = ps, t1 = ps + 4, t2 = ps + 8;
      if (t0 < NT) SU_LOADX(xa, KSEL, t0);
      if (t1 < NT) SU_LOADX(xb, KSEL, t1);
      if (t2 < NT) SU_LOADX(xc, KSEL, t2);
      while (t0 < NT) {
          SU_NORM(xa, t0); t0 += 12; if (t0 < NT) SU_LOADX(xa, KSEL, t0);
          if (t1 < NT) { SU_NORM(xb, t1); t1 += 12; if (t1 < NT) SU_LOADX(xb, KSEL, t1); }
          if (t2 < NT) { SU_NORM(xc, t2); t2 += 12; if (t2 < NT) SU_LOADX(xc, KSEL, t2); }
      } }
    if (wid >= 2) {
        f32x4 ka[8][2], va[8][2];
        const int gl = (wid - 2) >> 1;
        int tl = gl;
        if (tl < NT) { SU_LOADX(ka, KSEL, tl); SU_LOADX(va, VSEL, tl); }
        __syncthreads();
        if (wid == 2) {
            float a = lane < NT ? fmaxf(kpart[2 * lane], kpart[2 * lane + 1]) : 0.f, b = 64 + lane < NT ? fmaxf(kpart[128 + 2 * lane], kpart[129 + 2 * lane]) : 0.f;
#pragma unroll
            for (int o = 1; o < 64; o <<= 1) { const float na = __shfl_down(a, o), nb = __shfl_down(b, o); if (lane + o < 64) { a = fmaxf(a, na); b = fmaxf(b, nb); } }
            a = fmaxf(a, __shfl(b, 0));
            kinf[lane] = sqrtf(a) * 1.004f; kinf[64 + lane] = sqrtf(b) * 1.004f;
        }
        __syncthreads();
        for (int t = 0; t < NT; ++t) {
            if (t == tl) {
                const int bf = t & 1;
#pragma unroll
                for (int i = 0; i < 8; ++i) *(bf16x8*)(K_lds + bf * SHM_K + KSWZ(i * 8 + key0, sc * 2)) = pack8(ka[i][0], ka[i][1]);
#pragma unroll
                for (int i = 0; i < 8; ++i) *(bf16x8*)(V_lds + bf * SHM_V + v_st(i * 8 + key0, sc)) = pack8(va[i][0], va[i][1]);
                tl += 3; if (tl < NT) { SU_LOADX(ka, KSEL, tl); SU_LOADX(va, VSEL, tl); }
            }
            __syncthreads();
            if (SU_EXIT(t)) break;
        }
#undef SU_LOADX
#undef SU_NORM
    } else {
        float* ws = (float*)(lds + LDS_WS) + wid * 64; float* li_l = ws, * al_l = ws + 32;
        const char* bl = lds + LDS_BIAS + hi * 16;
        const int qlo = cur.P0 + wid * QBLK, qm = qlo + r32 - 4 * hi;
        const int vb0 = (int)(uintptr_t)V_lds + v_rd_base(lane);
        bf16x8 qr[8];
        { const bf16_t* qp = QROWP(cur);
#pragma unroll
          for (int d0 = 0; d0 < 8; ++d0) qr[d0] = ld8h(qp + d0 * 16); }
        float qn = 0.f;
#pragma unroll
        for (int d0 = 0; d0 < 8; ++d0) { const u32x4 w = __builtin_bit_cast(u32x4, qr[d0]);
#define SQ2(x) (__uint_as_float((x) << 16) * __uint_as_float((x) << 16) + __uint_as_float((x) & 0xffff0000u) * __uint_as_float((x) & 0xffff0000u))
            qn += (SQ2(w.x) + SQ2(w.y)) + (SQ2(w.z) + SQ2(w.w)); }
#undef SQ2
        { auto rr = __builtin_amdgcn_permlane32_swap(__float_as_uint(qn), __float_as_uint(qn), false, false); qn = sqrtf(__uint_as_float(rr[0]) + __uint_as_float(rr[1])) * 1.0001f; }
        float m_reg = -1e30f, l_reg = 0; f32x16 o[4] = {};
        __syncthreads();
        __syncthreads();
        f32x16 p0, p1; float mn, al; bf16x8 pa0, pa1, pa2, pa3;
#define SU_RESC(a) do { if (__any((a) < 1.f)) { if (hi == 0) al_l[r32] = (a); asm volatile("s_waitcnt lgkmcnt(0)" ::: "memory");              \
                     for (int d_ = 0; d_ < 4; ++d_) for (int r = 0; r < 16; ++r) o[d_][r] *= al_l[crow(r, hi)]; } } while (0)
#define SU_BODY(KB, t) do { SBAR(); qkt<KB>(p0, p1, K_lds, bl + KBASE(t) * 4, r32, hi, qr);                                                      \
            { const int kb_ = KBASE(t); if (kb_ + KVBLK - 1 > qlo) mask_tile(p0, p1, qm - kb_, WINF); }                                        \
            if (partialSM(p0, p1, m_reg, mn, al)) { SU_RESC(al); finishSM(p0, p1, al, l_reg, pa0, pa1, pa2, pa3); SBAR();       \
            pv_tile<KB>(o, vb0, pa0, pa1, pa2, pa3); } SBAR(); } while (0)
        for (int t = 0; t < NT; ++t) {
            __syncthreads();
            if (SU_EXIT(t)) break;
            if (t & 1) SU_BODY(1, t); else SU_BODY(0, t);
            { bool ok = true;
              if (t + 1 < NT) { const float ub = qn * kinf[t + 1] + ((const float*)(lds + LDS_BIAS))[KBASE(t + 1) + KVBLK - 1]; ok = ub <= m_reg - DELTA_RAW; }
              const bool okw = __all(ok); if (lane == 0) votes[(t & 1) * 2 + wid] = okw ? 1u : 0u; }
        }
#undef SU_BODY
#undef SU_RESC
        if (hi == 0) li_l[r32] = l_reg; asm volatile("s_waitcnt lgkmcnt(0)" ::: "memory");
        float rli[16];
#pragma unroll
        for (int r = 0; r < 16; ++r) rli[r] = __builtin_amdgcn_rcpf(li_l[crow(r, hi)]);
        typedef __attribute__((address_space(1))) bf16_t gbf16_t;
        gbf16_t* Ow = (gbf16_t*)(cur.O + (size_t)(wid * QBLK + 4 * hi) * g.ldo + r32); const gbf16_t* Gw = (const gbf16_t*)(cur.G + (size_t)(wid * QBLK + 4 * hi) * cur.ldg + r32);
        asm volatile("" : "+v"(Ow), "+v"(Gw));
        unsigned short gq[16][4];
#pragma unroll
        for (int r = 0; r < 16; ++r) { const int orow = (r & 3) + 8 * (r >> 2);
#pragma unroll
            for (int d0 = 0; d0 < 4; ++d0) gq[r][d0] = Gw[(size_t)orow * cur.ldg + d0 * 32]; }
        SBAR();
#pragma unroll
        for (int r = 0; r < 16; ++r) { const int orow = (r & 3) + 8 * (r >> 2);
#pragma unroll
            for (int d0 = 0; d0 < 4; ++d0) { const float v = o[d0][r] * rli[r] * __uint_as_float((unsigned)gq[r][d0] << 16); Ow[(size_t)orow * g.ldo + (size_t)(d0 >> 1) * g.sdo + (d0 & 1) * 32] = (bf16_t)(cvtpk(v, v) & 0xffffu); } }
    }
#undef SU_EXIT
#undef KBASE
    __syncthreads();
}
#undef ROW
#undef KSEL
#undef VSEL
#undef VMW
#undef VMWN
#undef SLOAD_H
#undef SWRITE_HK
#undef SWRITE_HV
#undef SWRITE_H
#undef SLOAD_F
#undef SLOAD_G
#undef SWRITE_KF
#undef SWRITE_VF
#undef QROWP
#undef KSWZ
#undef SBAR
}
#define GAS __attribute__((address_space(1)))
#define LAS __attribute__((address_space(3)))
typedef unsigned short bf16;
typedef unsigned v4u __attribute__((ext_vector_type(4)));
typedef float f32x4 __attribute__((ext_vector_type(4)));
typedef short bf16x8 __attribute__((ext_vector_type(8)));
typedef GAS unsigned gu32;
typedef GAS unsigned long long gu64;
#define RLX_AGENT __ATOMIC_RELAXED, __HIP_MEMORY_SCOPE_AGENT
#define LDS_WAIT() asm volatile("s_waitcnt lgkmcnt(0)" ::: "memory")
#define VM_WAIT() asm volatile("s_waitcnt vmcnt(0)" ::: "memory")
__device__ __forceinline__ unsigned long long rt() { return __builtin_amdgcn_s_memrealtime(); }
__device__ __forceinline__ unsigned f2bf(float f) { unsigned u = __builtin_bit_cast(unsigned, f); return (u + 0x7fffu + ((u >> 16) & 1u)) >> 16; }
__device__ __forceinline__ unsigned pk2(float lo, float hi) { return f2bf(lo) | (f2bf(hi) << 16); }

#define XB_TMO      128
#define XB_XCNT(j)  (256  + 64 * (j))
#define XB_XSUB(j)  (1280 + 64 * (j))
#define XB_XGEN(j)  (2304 + 64 * (j))
#define XB_TOP      3328
#define XB_TOPGEN   3392
#define XCD_BAR_WORDS 3456
#define XB_SPIN_CAP (1u << 18)

__device__ __forceinline__ unsigned xb_ld(unsigned* p)              { return __hip_atomic_load(p, __ATOMIC_RELAXED, __HIP_MEMORY_SCOPE_AGENT); }
__device__ __forceinline__ unsigned xb_add(unsigned* p, unsigned v) { return __hip_atomic_fetch_add(p, v, __ATOMIC_RELAXED, __HIP_MEMORY_SCOPE_AGENT); }
__device__ __forceinline__ unsigned xb_xcc_id() { return (unsigned)__builtin_amdgcn_s_getreg((3 << 11) | 20) & 0xFu; }
#define XB_SPIN(cond, bar) do { unsigned _sp = 0; while (cond) { __builtin_amdgcn_s_sleep(1); \
    if ((++_sp & 255u) == 0u) { if (xb_ld(&(bar)[XB_TMO])) break; if (_sp > XB_SPIN_CAP) { atomicAdd(&(bar)[XB_TMO], 1u); break; } } } } while (0)

struct XcdBarrier {
    unsigned* bar; unsigned x;
    volatile LAS unsigned* st;
};

__device__ __forceinline__ XcdBarrier xcd_barrier_post(unsigned* bar, volatile LAS unsigned* st) {
    XcdBarrier b; b.bar = bar; b.x = xb_xcc_id(); b.st = st;
    if (threadIdx.x == 0) (void)xb_add(&bar[XB_XCNT(b.x)], 1u);
    return b;
}
__device__ __forceinline__ void xcd_barrier_complete(unsigned* bar, unsigned x, unsigned& nloc, unsigned& nx) {
    const unsigned G = gridDim.x * gridDim.y * gridDim.z;
    unsigned sum, cnt, mine, sp = 0u;
    for (;;) {
        sum = 0u; cnt = 0u; mine = 0u;
#pragma unroll
        for (unsigned j = 0; j < 16; ++j) { const unsigned c = xb_ld(&bar[XB_XCNT(j)]); sum += c; cnt += (c > 0u) ? 1u : 0u; mine = (j == x) ? c : mine; }
        if (sum == G) break;
        __builtin_amdgcn_s_sleep(1);
        if ((++sp & 255u) == 0u) { if (xb_ld(&bar[XB_TMO])) break; if (sp > XB_SPIN_CAP) { atomicAdd(&bar[XB_TMO], 1u); break; } }
    }
    nloc = mine > 0u ? mine : 1u; nx = cnt > 0u ? cnt : 1u;
}

__device__ __forceinline__ void xcd_barrier(const XcdBarrier& b) {
    asm volatile("s_waitcnt vmcnt(0)" ::: "memory");
    __syncthreads();
    if (threadIdx.x == 0) {
        unsigned* bar = b.bar;
        __builtin_amdgcn_s_waitcnt(0);
        unsigned nloc = b.st[0], nx = b.st[1];
        if (nloc == 0u) { xcd_barrier_complete(bar, b.x, nloc, nx); b.st[0] = nloc; b.st[1] = nx; }
        const unsigned old = xb_add(&bar[XB_XSUB(b.x)], 1u);
        const unsigned gen = old / nloc;
        if (old + 1u == (gen + 1u) * nloc) {
            __builtin_amdgcn_fence(__ATOMIC_RELEASE, "agent");
            asm volatile("s_waitcnt vmcnt(0)" ::: "memory");
            const unsigned og = xb_add(&bar[XB_TOP], 1u);
            const unsigned tg = og / nx;
            if (og + 1u == (tg + 1u) * nx) xb_add(&bar[XB_TOPGEN], 1u);
            else XB_SPIN(xb_ld(&bar[XB_TOPGEN]) == tg, bar);
            __builtin_amdgcn_fence(__ATOMIC_ACQUIRE, "agent");
            xb_add(&bar[XB_XGEN(b.x)], 1u);
            asm volatile("s_waitcnt vmcnt(0)" ::: "memory");
        } else {
            XB_SPIN(xb_ld(&bar[XB_XGEN(b.x)]) == gen, bar);
            __builtin_amdgcn_fence(__ATOMIC_ACQUIRE, "agent");
            asm volatile("s_waitcnt vmcnt(0)" ::: "memory");
        }
    }
    __syncthreads();
}

constexpr int NWAVES = 8;
constexpr int RING_OFF = 0, RING_BYTES = 131072;
constexpr int LDSCTL_OFF = RING_BYTES, MISC_OFF = LDSCTL_OFF + 320;
constexpr int LDS_BYTES = 147456;
static_assert(MISC_OFF + 128 <= LDS_BYTES && fa::LDS_BYTES <= RING_BYTES && pg8::STAGE_BYTES <= RING_BYTES, "LDS map");
constexpr int N_PHASES = 9;
constexpr int N_LAUNCHES = MK_N_LAUNCHES;

struct Args { const float* in[20]; float* out; unsigned char* ws; int ph_lo, ph_hi; };
static_assert(sizeof(Args) == 22 * 8 + 8, "Args has no padding");

__device__ __forceinline__ float wave_sum(float v) {
#pragma unroll
    for (int o = 1; o < 64; o <<= 1) v += __shfl_xor(v, o);
    return v;
}
typedef unsigned u32x2_ __attribute__((ext_vector_type(2)));
__device__ __forceinline__ float bf_lo(unsigned u) { return __uint_as_float(u << 16); }
__device__ __forceinline__ float bf_hi(unsigned u) { return __uint_as_float(u & 0xffff0000u); }

__device__ __forceinline__ int p8_row(int l) { const int w = l & 31, fq = w >> 3, n = (w >> 2) & 1, i = w & 3; return (l & ~31) + 16 * n + 4 * fq + i; }
__device__ __forceinline__ int wa_row(int n) {
    if (n >= 4 * CD) return p8_row(n);
    const int qi = n / CD, c = n % CD, pn = c >> 6, ch = c & 63, wc = ch >> 4, fq = (ch >> 2) & 3, i = ch & 3, bj = qi >> 1, nn = qi & 1;
    return 256 * pn + 128 * bj + 32 * wc + 16 * nn + 4 * fq + i;
}
template <int MODE>
__device__ __forceinline__ void p0_transpose_item(const float* W, int ldw, const float* gain, bf16* WT, int wt_rows, int row_off, LAS float* scr, int k0, int n0, int lane) {
    const int lr = lane >> 4, lc = (lane & 15) * 4;
#pragma unroll 4
    for (int it = 0; it < 16; ++it) { const int kk = 4 * it + lr; const float gv = gain ? gain[k0 + kk] : 1.0f;
        const f32x4 v = *(const GAS f32x4*)(W + (size_t)(k0 + kk) * ldw + n0 + lc) * gv;
        *(LAS f32x4*)(scr + kk * 64 + (lc ^ (4 * ((kk >> 3) & 7)))) = v; }
    LDS_WAIT(); asm volatile("" ::: "memory");
    const int c = lane & 7;
#pragma unroll
    for (int j = 0; j < 8; ++j) { const int n = (lane >> 3) + 8 * j; const LAS float* s = scr + (8 * c) * 64 + (n ^ (4 * c));
        v4u o; o.x = pk2(s[0 * 64], s[1 * 64]); o.y = pk2(s[2 * 64], s[3 * 64]); o.z = pk2(s[4 * 64], s[5 * 64]); o.w = pk2(s[6 * 64], s[7 * 64]);
        const int dr = MODE == 1 ? wa_row(n0 + n) : row_off + p8_row(n0 + n);
        *(GAS v4u*)(WT + ktm(dr, k0 + 8 * c, wt_rows)) = o; }
    LDS_WAIT(); asm volatile("" ::: "memory");
}
__device__ __forceinline__ void rms_row_to_bf16(const float* xrow, bf16* obase, int row, int nrows, int lane) {
    const GAS f32x4* xr = (const GAS f32x4*)xrow + lane;
    f32x4 v[8]; float s = 0.f;
#pragma unroll
    for (int j = 0; j < 8; ++j) { v[j] = xr[64 * j]; s += (v[j].x * v[j].x + v[j].y * v[j].y) + (v[j].z * v[j].z + v[j].w * v[j].w); }
    const float rstd = 1.0f / sqrtf(wave_sum(s) * (1.f / DM) + EPS);
    GAS bf16* o8 = (GAS bf16*)obase + ktm(row, 4 * lane, nrows);
#pragma unroll
    for (int j = 0; j < 8; ++j) *(GAS unsigned long long*)(o8 + (size_t)(4 * j) * nrows * 64) = (unsigned long long)pk2(v[j].x * rstd, v[j].y * rstd) | ((unsigned long long)pk2(v[j].z * rstd, v[j].w * rstd) << 32);
}
__device__ __forceinline__ float log_sigmoid(float v) { return v >= 0.f ? -log1pf(expf(-v)) : v - log1pf(expf(v)); }

__global__ void __launch_bounds__(NWAVES * 64, 2) yoco_fwd(Args args) {
    extern __shared__ __attribute__((aligned(16))) unsigned char lds[];
    LAS unsigned char* const ldsl = (LAS unsigned char*)lds;
    volatile LAS unsigned* const MISC = (volatile LAS unsigned*)(ldsl + MISC_OFF);
    const int wave = __builtin_amdgcn_readfirstlane(threadIdx.x >> 6);
    const int G = gridDim.x; const int bx = blockIdx.x; const int vcu = (G % 8 == 0) ? (bx % 8) * (G / 8) + bx / 8 : bx;
    const int gw = vcu * NWAVES + wave, NGW = G * NWAVES;
    gu32* const ctl = (gu32*)(args.ws + WS_CTL);
#define LANE() ((int)__builtin_amdgcn_mbcnt_hi(~0u, __builtin_amdgcn_mbcnt_lo(~0u, 0u)))
#define PHASE_ENV() const __attribute__((address_space(4))) Args* ap = (const __attribute__((address_space(4))) Args*)__builtin_amdgcn_kernarg_segment_ptr(); asm volatile("" : "+s"(ap)); \
    unsigned char* const ws = ap->ws; float* const dout = ap->out; int tid = threadIdx.x; asm volatile("" : "+v"(tid)); const int lane = tid & 63; (void)ws; (void)dout; (void)lane
#define INP(k) (ap->in[k])
#define WSP(T, off) ((T*)(ws + (off)))

    for (int u = threadIdx.x; u < (LDS_BYTES - LDSCTL_OFF) / 4; u += NWAVES * 64) ((LAS unsigned*)(ldsl + LDSCTL_OFF))[u] = 0u;
    __syncthreads();
    XcdBarrier bar; bar.bar = (unsigned*)(ctl + CW_BAR); bar.x = 0; bar.st = nullptr;
    if (N_LAUNCHES == 1) bar = xcd_barrier_post((unsigned*)(ctl + CW_BAR), MISC + 8);
#define GRID_BAR() do { if (N_LAUNCHES == 1) xcd_barrier(bar); } while (0)
    const int lo = args.ph_lo, hi = args.ph_hi;
#ifndef PH_MASK
#define PH_MASK 0x1ff
#endif
#define IN(k) ((((PH_MASK) >> (k)) & 1) && lo <= (k) && (k) < hi)
#define BOTH(k) (IN(k) && IN((k) + 1))
#ifndef REP_MASK
#define REP_MASK 0x0
#endif
#ifndef SAMPLE_CUS_PER_XCD
#define SAMPLE_CUS_PER_XCD 12
#endif
#ifndef REP_SAMPLE
#define REP_SAMPLE 0
#endif
#ifndef REP_FOX
#define REP_FOX 0
#endif
#define REPS(k) _Pragma("unroll") for (int rep_ = 0; rep_ < ((((REP_MASK) >> (k)) & 1) ? 2 : 1); ++rep_)

    REPS(0) if (IN(0)) {
        PHASE_ENV();
        const float* x_prompt = INP(0); const float* x_sample = INP(1); const float* cache_mem_k = INP(6); const float* cache_mem_v = INP(7); const float* mem_prompt = INP(8); const float* g_norm = INP(9);
        const float* w_in_a = INP(10); const float* w_in_b = INP(12); const float* w_out = INP(13); const float* g_mem = INP(14); const float* w_mem_kv = INP(15); const float* g_kv = INP(16); const float* w_kvf = INP(17);
        bf16* const WA = WSP(bf16, WS_WA); bf16* const WB = WSP(bf16, WS_WB); bf16* const WO = WSP(bf16, WS_WO); float* const WF = WSP(float, WS_WF); bf16* const XN = WSP(bf16, WS_XN); bf16* const MEMK = WSP(bf16, WS_MEMK); bf16* const MEMV = WSP(bf16, WS_MEMV);
        LAS float* scr = (LAS float*)(ldsl + RING_OFF + wave * 16384);
        constexpr int KB_ = DM / 64;
        constexpr int I_A = KB_ * (INA / 64), I_O = KB_ * (DM / 64), I_M = KB_ * (2 * MD / 64);
        constexpr int NITEMS = I_A + I_O + 2 * I_M;
        for (int it = gw; it < NITEMS; it += NGW) {
            int r = it;
            if (r < I_A) { p0_transpose_item<1>(w_in_a, INA, g_norm, WA, WA_ROWS, 0, scr, 64 * (r / (INA / 64)), 64 * (r % (INA / 64)), lane); continue; } r -= I_A;
            if (r < I_O) { p0_transpose_item<0>(w_out, DM, nullptr, WO, DM, 0, scr, 64 * (r / (DM / 64)), 64 * (r % (DM / 64)), lane); continue; } r -= I_O;
            { const int l = r / I_M; r -= l * I_M; p0_transpose_item<0>(w_mem_kv + (size_t)l * DM * 2 * MD, 2 * MD, g_mem + l * DM, WA, WA_ROWS, INA + l * 2 * MD, scr, 64 * (r / (2 * MD / 64)), 64 * (r % (2 * MD / 64)), lane); }
        }
#define P0_ROW(m_) ((const GAS f32x4*)((m_) < MP ? x_prompt + (size_t)(m_) * DM : ((m_) < MT ? x_sample + (size_t)((m_) - MP) * DM : mem_prompt + (size_t)((m_) - MT) * DM)) + lane)
        { f32x4 xa[8];
          { const GAS f32x4* xr = P0_ROW(gw < XN_ROWS ? gw : 0);
#pragma unroll
            for (int j = 0; j < 8; ++j) xa[j] = xr[64 * j]; }
          for (int m = gw; m < XN_ROWS; m += NGW) {
              f32x4 xb[8];
              { const GAS f32x4* xr = P0_ROW(m + NGW < XN_ROWS ? m + NGW : m);
#pragma unroll
                for (int j = 0; j < 8; ++j) xb[j] = xr[64 * j]; }
              float s = 0.f;
#pragma unroll
              for (int j = 0; j < 8; ++j) s += (xa[j].x * xa[j].x + xa[j].y * xa[j].y) + (xa[j].z * xa[j].z + xa[j].w * xa[j].w);
              const float rstd = 1.0f / sqrtf(wave_sum(s) * (1.f / DM) + EPS);
              if (lane == 0 && m < MT) WSP(float, WS_RS0)[m] = rstd;
              GAS bf16* o8 = (GAS bf16*)XN + ktm(m, 4 * lane, XN_ROWS);
#pragma unroll
              for (int j = 0; j < 8; ++j) *(GAS unsigned long long*)(o8 + (size_t)(4 * j) * XN_ROWS * 64) = (unsigned long long)pk2(xa[j].x * rstd, xa[j].y * rstd) | ((unsigned long long)pk2(xa[j].z * rstd, xa[j].w * rstd) << 32);
#pragma unroll
              for (int j = 0; j < 8; ++j) xa[j] = xb[j];
          } }
#undef P0_ROW
        { constexpr int PER = NMEM * MD / 8;
          for (int i = gw * 64 + lane; i < 2 * SB * PER; i += NGW * 64) {
              const int kv = i / (SB * PER), r = i % (SB * PER), b = r / PER, e = r % PER;
              const float* src = (kv ? cache_mem_v : cache_mem_k) + ((size_t)b * PER + e) * 8; bf16* dst = (kv ? MEMV : MEMK) + ((size_t)(PB + b) * PER + e) * 8;
              const f32x4 a = *(const f32x4*)src, c = *(const f32x4*)(src + 4); v4u o; o.x = pk2(a.x, a.y); o.y = pk2(a.z, a.w); o.z = pk2(c.x, c.y); o.w = pk2(c.z, c.w); *(v4u*)dst = o; } }
        for (int i = gw * 64 + lane; i < 16 * DM; i += NGW * 64) { const int j = i / DM, k = i % DM; const float v = j < NHF ? g_kv[k] * w_kvf[(size_t)k * KVF + 2 * CD + j] : 0.f;
            ((unsigned short*)WF)[((k >> 5) * 16 + j) * 32 + (k & 31)] = (unsigned short)(pk2(v, 0.f) & 0xffffu); }
        if (BOTH(0)) GRID_BAR();
    }

    REPS(1) if (IN(1)) {
        PHASE_ENV();
        bf16* const XN = WSP(bf16, WS_XN); bf16* const WA = WSP(bf16, WS_WA);
        pg8::Gemm g{XN, WA, XN_ROWS, WA_ROWS, DM}; pg8::GridOrder S; S.init(MP / 256, INA / 256, G, bx, 8 * 28, MP, 0, 28, 4 * 8, MT, 28, 8);
        pg8::EpiA E{WSP(bf16, WS_MIX), WSP(bf16, WS_QM), WSP(bf16, WS_SZM), WSP(bf16, WS_MEMK), WSP(bf16, WS_MEMV), dout, WSP(float, WS_FCU), WSP(float, WS_FBZ), WSP(float, WS_LCU), INP(11)};
        pg8::gemm_phase<pg8::EpiA, pg8::GridOrder, true, true>(ldsl + RING_OFF, g, S, E);
        if (BOTH(1)) GRID_BAR();
    }

    REPS(2) if (IN(2)) {
        PHASE_ENV();
        const float* state_conv = INP(2); const float* conv_w = INP(11);
        bf16* const QMb = WSP(bf16, WS_QM); bf16* const SZMb = WSP(bf16, WS_SZM); bf16* const MIX = WSP(bf16, WS_MIX); bf16* const MEMK = WSP(bf16, WS_MEMK); bf16* const MEMV = WSP(bf16, WS_MEMV);
        { const float* const FCU = WSP(float, WS_FCU); const float* const FBZ = WSP(float, WS_FBZ); const float* const LCU = WSP(float, WS_LCU);
          for (int it = gw; it < (MT / 64) * 3; it += NGW) {
            const int g64 = it / 3, cc = it % 3, r0 = g64 * 64, c0 = cc * 512 + lane * 8;
            float w0[8], w1[8], w2[8], h2[8], h1[8], cu0[8], cu1[8], bz0[8], bz1[8];
#pragma unroll
            for (int j = 0; j < 8; ++j) { w0[j] = conv_w[c0 + j]; w1[j] = conv_w[CD + c0 + j]; w2[j] = conv_w[2 * CD + c0 + j]; }
            const bool pr = r0 < MP;
            if (pr && (r0 & (PT - 1)) == 0) {
#pragma unroll
                for (int j = 0; j < 8; ++j) { h2[j] = 0.f; h1[j] = 0.f; } }
            else { const float* sp = pr ? LCU + (size_t)(g64 - 1) * 2 * CD + c0 : state_conv + (size_t)((r0 - MP) / ST) * 2 * CD + c0;
#pragma unroll
                for (int j = 0; j < 8; ++j) { h2[j] = sp[j]; h1[j] = sp[CD + j]; } }
            { const float* fc = FCU + (size_t)g64 * 2 * CD + c0; const float* fb = FBZ + (size_t)g64 * 2 * CD + c0;
#pragma unroll
              for (int j = 0; j < 8; ++j) { cu0[j] = fc[j]; cu1[j] = fc[CD + j]; bz0[j] = fb[j]; bz1[j] = fb[CD + j]; } }
            float o0[8], o1[8];
#pragma unroll
            for (int j = 0; j < 8; ++j) { o0[j] = bz0[j] * (w0[j] * h2[j] + w1[j] * h1[j] + w2[j] * cu0[j]); o1[j] = bz1[j] * (w0[j] * h1[j] + w1[j] * cu0[j] + w2[j] * cu1[j]); }
            v4u w; w.x = pk2(o0[0], o0[1]); w.y = pk2(o0[2], o0[3]); w.z = pk2(o0[4], o0[5]); w.w = pk2(o0[6], o0[7]); *(v4u*)(MIX + ktm(r0, c0, MT)) = w;
            w.x = pk2(o1[0], o1[1]); w.y = pk2(o1[2], o1[3]); w.z = pk2(o1[4], o1[5]); w.w = pk2(o1[6], o1[7]); *(v4u*)(MIX + ktm(r0 + 1, c0, MT)) = w;
          } }
        {
            __syncthreads();
            const fa::Geom gm{64, 0x7fffffff, (size_t)MT * 64};
            auto mk = [=](int idx) { const int blk = idx >> 2, h = idx & 3; const bool pr = blk < 64; const int row0 = pr ? blk * 256 : MP + (blk - 64) * ST, mb = pr ? (blk >> 5) : PB + (blk - 64);
                fa::BlockRef<fa::bf16_t> r; r.Q = QMb + (size_t)row0 * MD + h * HD; r.K = MEMK + (size_t)(0 * NMB + mb) * NMEM * MD + h * HD; r.V = MEMV + (size_t)(0 * NMB + mb) * NMEM * MD + h * HD; r.K2 = r.K; r.V2 = r.V;
                r.O = MIX + ktm(row0, CD + h * HD, MT); r.G = SZMb + (size_t)row0 * MD + h * HD; r.bias = nullptr; r.kmax = nullptr; r.P0 = 1 << 20; r.skv = NMEM; r.nvalid = pr ? 256 : ST; r.ldq = MD; r.ldk = MD; r.ldg = MD; return r; };
            if (vcu < 320) {
                fa::Seam<fa::bf16_t> Sm; fa::BlockRef<fa::bf16_t> cur = mk(vcu); fa::attn_prime<fa::bf16_t>(cur, gm, (char*)lds + RING_OFF, Sm);
                for (int idx = vcu; idx < 320; idx += G) { const bool more = idx + G < 320; const fa::BlockRef<fa::bf16_t> nxt = more ? mk(idx + G) : cur;
                    fa::attn_block<fa::bf16_t, false, fa::NoQueue>(cur, nxt, gm, (char*)lds + RING_OFF, Sm, fa::NoQueue{}); cur = nxt; }
            }
        }
        if (BOTH(2)) GRID_BAR();
    }

    REPS(3) if (IN(3)) {
        PHASE_ENV();
        bf16* const MIX = WSP(bf16, WS_MIX); bf16* const WO = WSP(bf16, WS_WO);
        pg8::Gemm g{MIX, WO, MT, DM, DM}; pg8::GridOrder S; S.init(MP / 256, DM / 256, G, bx, 8 * 8, MP, 0, 8);
        pg8::EpiX1 E{WSP(bf16, WS_XN), XN_ROWS, WSP(float, WS_RS0), WSP(bf16, WS_XU), WSP(float, WS_CTL) + CW_SS1};
        pg8::gemm_phase<pg8::EpiX1, pg8::GridOrder, true, true>(ldsl + RING_OFF, g, S, E);
        const int cv0 = G > 64 ? 64 : 0;
        if (bx >= cv0) {
            const float* w_in_b = INP(12); const float* w_out = INP(13); const float* g_norm = INP(9); const float* g_kv = INP(16); const float* w_kvf = INP(17); const float* cache_mem_k = INP(6); const float* cache_mem_v = INP(7);
            bf16* const WB = WSP(bf16, WS_WB); bf16* const MEMK = WSP(bf16, WS_MEMK); bf16* const MEMV = WSP(bf16, WS_MEMV);
            LAS float* scr = (LAS float*)(ldsl + RING_OFF + wave * 16384);
            const int w2 = (bx - cv0) * NWAVES + wave, NW2 = (G - cv0) * NWAVES;
            constexpr int KB_ = DM / 64; constexpr int I_KV = KB_ * (2 * CD / 64), I_B = KB_ * (INB / 64), I_O = KB_ * (DM / 64);
            for (int it = w2; it < I_KV + I_B + I_O; it += NW2) {
                int r = it;
                if (r < I_KV) { p0_transpose_item<0>(w_kvf, KVF, g_kv, WB, INA, 0, scr, 64 * (r / (2 * CD / 64)), 64 * (r % (2 * CD / 64)), lane); continue; } r -= I_KV;
                if (r < I_B) { p0_transpose_item<0>(w_in_b, INB, g_norm + DM, WB, INA, 2 * CD, scr, 64 * (r / (INB / 64)), 64 * (r % (INB / 64)), lane); continue; } r -= I_B;
                p0_transpose_item<0>(w_out + (size_t)DM * DM, DM, nullptr, WO + (size_t)DM * DM, DM, 0, scr, 64 * (r / (DM / 64)), 64 * (r % (DM / 64)), lane);
            }
            constexpr int PER = NMEM * MD / 8;
            for (int i = w2 * 64 + lane; i < 2 * SB * PER; i += NW2 * 64) {
                const int kv = i / (SB * PER), r = i % (SB * PER), b = r / PER, e = r % PER;
                const float* src = (kv ? cache_mem_v : cache_mem_k) + ((size_t)(SB + b) * PER + e) * 8; bf16* dst = (kv ? MEMV : MEMK) + ((size_t)(NMB + PB + b) * PER + e) * 8;
                const f32x4 a = *(const f32x4*)src, c = *(const f32x4*)(src + 4); v4u o; o.x = pk2(a.x, a.y); o.y = pk2(a.z, a.w); o.z = pk2(c.x, c.y); o.w = pk2(c.z, c.w); *(v4u*)dst = o; }
        }
        if (BOTH(3)) GRID_BAR();
    }

    REPS(4) if (IN(4)) {
        PHASE_ENV();
        const float* b_f = INP(18); const float* const WF = WSP(float, WS_WF); const bf16* const XU = WSP(bf16, WS_XU); const float* const SS1 = WSP(float, WS_CTL) + CW_SS1;
        const int fr = lane & 15, fq = lane >> 4;
        const int gi = wave * G + bx;
        const bool has = gi < MT / 16; const int row = (has ? gi : 0) * 16 + fr;
        const GAS bf16* xp = (const GAS bf16*)XU + ktm(row, fq * 8, MT);
#define P4_X(ks) (*(const GAS pg8::bf16x8*)(xp + (size_t)((ks) >> 1) * MT * 64 + ((ks) & 1) * 32))
        pg8::bf16x8 xa[16], xb[16];
#pragma unroll
        for (int k = 0; k < 16; ++k) xa[k] = P4_X(k);
#pragma unroll
        for (int k = 0; k < 16; ++k) xb[k] = P4_X(16 + k);
        const float ssr = SS1[row]; f32x4 bfv = {0.f, 0.f, 0.f, 0.f}; if (fq < 3) bfv = *(const f32x4*)(b_f + fq * 4);
        LAS unsigned* wl = (LAS unsigned*)(ldsl + RING_OFF);
        { v4u wv[8];
#pragma unroll
          for (int j = 0; j < 8; ++j) wv[j] = ((const v4u*)WF)[tid + NWAVES * 64 * j];
#pragma unroll
          for (int j = 0; j < 8; ++j) ((LAS v4u*)wl)[tid + NWAVES * 64 * j] = wv[j]; }
        __syncthreads();
        const LAS unsigned char* wb = (const LAS unsigned char*)wl + fr * 64 + fq * 16;
        f32x4 acc = {0.f, 0.f, 0.f, 0.f};
#define P4_MM(xs, k0) _Pragma("unroll") for (int k = 0; k < 16; ++k) acc = __builtin_amdgcn_mfma_f32_16x16x32_bf16(*(const LAS pg8::bf16x8*)(wb + ((k0) + k) * 1024), xs[k], acc, 0, 0, 0)
        P4_MM(xa, 0);
#pragma unroll
        for (int k = 0; k < 16; ++k) xa[k] = P4_X(32 + k);
        P4_MM(xb, 16);
#pragma unroll
        for (int k = 0; k < 16; ++k) xb[k] = P4_X(48 + k);
        P4_MM(xa, 32);
        P4_MM(xb, 48);
#undef P4_MM
#undef P4_X
        if (has && fq < 3) {
            const float rstd = 1.0f / sqrtf(ssr * (1.f / DM) + EPS);
            f32x4 lf;
#pragma unroll
            for (int r = 0; r < 4; ++r) lf[r] = log_sigmoid(acc[r] * rstd + bfv[r]);
            float* dst = row < MP ? dout + OO_PLOGF + (size_t)row * NHF : dout + OO_SLOGF + (size_t)(row - MP) * NHF;
            *(f32x4*)(dst + fq * 4) = lf;
        }
        __syncthreads();
        if (BOTH(4)) GRID_BAR();
    }

    REPS(5) if (IN(5)) {
        PHASE_ENV();
        const bool ovl = N_LAUNCHES == 1 && BOTH(5) && (REP_MASK & 0xe0) == 0;
        const float* cache_logf = INP(5); bf16* const XU = WSP(bf16, WS_XU); bf16* const WB = WSP(bf16, WS_WB); float* const KBIAS = WSP(float, WS_KBIAS);
        gu32* const ctlw = (gu32*)(ws + WS_CTL);
        for (int pair = bx; pair < NMB * NHF; pair += G) {
            LAS float* tot = (LAS float*)(ldsl + RING_OFF);
            const int sq = pair / NHF, hh = pair % NHF; const bool pr = sq < PB; const int len = pr ? PT : SKV_S; const int t0 = tid * 16; const bool actv = t0 < len;
            float v[16]; float sum = 0.f;
            if (actv) { const float* src; if (pr) src = dout + OO_PLOGF + ((size_t)sq * PT + t0) * NHF + hh; else { const int b = sq - PB; src = (t0 < PAST ? cache_logf + ((size_t)b * PAST + t0) * NHF : dout + OO_SLOGF + ((size_t)b * ST + (t0 - PAST)) * NHF) + hh; }
#pragma unroll
                for (int r = 0; r < 16; ++r) { sum += src[r * NHF]; v[r] = sum; } }
            else {
#pragma unroll
                for (int r = 0; r < 16; ++r) v[r] = 0.f; }
            float inc = sum;
#pragma unroll
            for (int o = 1; o < 64; o <<= 1) { const float n = __shfl_up(inc, o); if (lane >= o) inc += n; }
            if (lane == 63) tot[wave] = inc;
            __syncthreads();
            float base = inc - sum; for (int w = 0; w < wave; ++w) base += tot[w];
            if (actv) { f32x4* dst = (f32x4*)(KBIAS + (pr ? (size_t)sq * NHF * PT : KBIAS_S_OFF + (size_t)(sq - PB) * NHF * SKV_S) + (size_t)hh * len + t0); const float ns = -1.0f / fa::SCALE;
#pragma unroll
                for (int q4 = 0; q4 < 4; ++q4) dst[q4] = (f32x4){(v[4 * q4] + base) * ns, (v[4 * q4 + 1] + base) * ns, (v[4 * q4 + 2] + base) * ns, (v[4 * q4 + 3] + base) * ns}; }
            __syncthreads();
        }
        pg8::EpiB E{ws, dout, (float*)(ws + WS_CTL) + CW_KN2, (const float*)(ws + WS_CTL) + CW_SS1};
        { pg8::Gemm g{XU, WB, MT, INA, DM}; pg8::GridOrder S; S.init(0, INA / 256, G, bx, 8 * 28, MP, 0, 28);
          pg8::gemm_phase<pg8::EpiB, pg8::GridOrder, true, true>(ldsl + RING_OFF, g, S, E); }
        if (ovl) { if (bx < 8 * 28) { asm volatile("s_waitcnt vmcnt(0)" ::: "memory"); __syncthreads();
            if (tid == 0) { __builtin_amdgcn_fence(__ATOMIC_RELEASE, "agent"); asm volatile("s_waitcnt vmcnt(0)" ::: "memory"); __hip_atomic_fetch_add(ctlw + CW_C2, 1u, RLX_AGENT); } } }
        { pg8::Gemm g{XU, WB, MT, INA, DM}; pg8::GridOrder S; S.init(MP / 256, INA / 256, G, bx);
          pg8::gemm_phase<pg8::EpiB, pg8::GridOrder, true, true>(ldsl + RING_OFF, g, S, E); }
        if (ovl) { asm volatile("s_waitcnt vmcnt(0)" ::: "memory"); __syncthreads();
            if (tid == 0) { __builtin_amdgcn_fence(__ATOMIC_RELEASE, "agent"); asm volatile("s_waitcnt vmcnt(0)" ::: "memory"); __hip_atomic_fetch_add(ctlw + CW_C1, 1u, RLX_AGENT); } }
        if (!ovl && BOTH(5)) GRID_BAR();
    }

    REPS(6) if (IN(6)) {
        PHASE_ENV();
        const float* cache_k = INP(3); const float* cache_v = INP(4);
        bf16* const QMb = WSP(bf16, WS_QM); bf16* const SZMb = WSP(bf16, WS_SZM); bf16* const MIX = WSP(bf16, WS_MIX); bf16* const KBb = WSP(bf16, WS_KB); bf16* const VBb = WSP(bf16, WS_VB);
        bf16* const QFb = WSP(bf16, WS_QF); bf16* const SZFb = WSP(bf16, WS_SZF); bf16* const MEMK = WSP(bf16, WS_MEMK); bf16* const MEMV = WSP(bf16, WS_MEMV); float* const KBIAS = WSP(float, WS_KBIAS);
        char* const al = (char*)lds + RING_OFF; gu32* const ctlw = (gu32*)(ws + WS_CTL);
        const bool ovl6 = N_LAUNCHES == 1 && IN(5) && (REP_MASK & 0xe0) == 0;
        const unsigned nC2 = (unsigned)(G < 8 * 28 ? G : 8 * 28);
#define WAIT_CTR(word_, want_) do { if (wave == 0) { unsigned sp_ = 0; while ((unsigned)__builtin_amdgcn_readfirstlane(__hip_atomic_load(ctlw + (word_), RLX_AGENT)) < (want_)) { __builtin_amdgcn_s_sleep(8); if (++sp_ > (1u << 22)) break; } \
            __builtin_amdgcn_fence(__ATOMIC_ACQUIRE, "agent"); asm volatile("s_waitcnt vmcnt(0)" ::: "memory"); } __syncthreads(); } while (0)
        const bool p7in6 = N_LAUNCHES == 1 && BOTH(6) && (REP_MASK & 0xe0) == 0 && ((G + 31) >> 5) * SAMPLE_CUS_PER_XCD >= 8 * 8;
        bool c2w = !ovl6;
        if (ovl6) WAIT_CTR(CW_C1, (unsigned)G);
        {
            const fa::Geom gs{64, PAST, (size_t)MT * 64};
            const int i = vcu & 31;
            const int nS = ((G + 31) >> 5) * SAMPLE_CUS_PER_XCD, sidx = (vcu >> 5) * SAMPLE_CUS_PER_XCD + i;
            const int UPC = (i < SAMPLE_CUS_PER_XCD && sidx < SB * NHF) ? (SB * NHF - sidx + nS - 1) / nS : 0;
            if (UPC > 0) {
                if (!c2w) { WAIT_CTR(CW_C2, nC2); c2w = true; }
                auto mks = [=](int k) { const int su = sidx + k * nS; const int b = su / NHF, h = su % NHF; const size_t row0 = (size_t)MP + (size_t)b * ST;
                    fa::BlockRef<float> r; r.Q = QFb + row0 * CD + h * HD; r.K = cache_k + (size_t)b * PAST * CD + h * HD; r.V = cache_v + (size_t)b * PAST * CD + h * HD;
                    r.K2 = dout + OO_SK + (size_t)b * ST * CD + h * HD - (size_t)PAST * CD; r.V2 = dout + OO_SV + (size_t)b * ST * CD + h * HD - (size_t)PAST * CD;
                    r.O = MIX + ktm((int)row0, h * HD, MT); r.G = SZFb + row0 * CD + h * HD; r.bias = KBIAS + KBIAS_S_OFF + (size_t)su * SKV_S; r.kmax = nullptr; r.P0 = PAST; r.skv = SKV_S; r.nvalid = ST; r.ldq = CD; r.ldk = CD; r.ldg = CD; return r; };
                for (int rs_ = 0; rs_ < 1 + REP_SAMPLE; ++rs_)
                for (int k = 0; k < UPC; ++k) fa::sample_unit(mks(k), gs, al);
            }
            if (p7in6 && i < SAMPLE_CUS_PER_XCD && sidx < nS) {
                if (!c2w) { WAIT_CTR(CW_C2, nC2); c2w = true; }
                const fa::Geom gm2{64, 0x7fffffff, (size_t)MT * 64};
                for (int it = sidx; it < SB * NHM; it += nS) {
                    const int blk = 64 + (it >> 2), h = it & 3; const int row0 = MP + (blk - 64) * ST, mb = PB + (blk - 64);
                    fa::BlockRef<fa::bf16_t> r; r.Q = QMb + (size_t)row0 * MD + h * HD; r.K = MEMK + (size_t)(1 * NMB + mb) * NMEM * MD + h * HD; r.V = MEMV + (size_t)(1 * NMB + mb) * NMEM * MD + h * HD; r.K2 = r.K; r.V2 = r.V;
                    r.O = MIX + ktm(row0, CD + h * HD, MT); r.G = SZMb + (size_t)row0 * MD + h * HD; r.bias = nullptr; r.kmax = nullptr; r.P0 = 1 << 20; r.skv = NMEM; r.nvalid = ST; r.ldq = MD; r.ldk = MD; r.ldg = MD;
                    __syncthreads(); fa::Seam<fa::bf16_t> Sm2; fa::attn_prime<fa::bf16_t>(r, gm2, al, Sm2); fa::attn_block<fa::bf16_t, false, fa::NoQueue>(r, r, gm2, al, Sm2, fa::NoQueue{});
                }
                asm volatile("s_waitcnt vmcnt(0)" ::: "memory"); __syncthreads();
                if (tid == 0) { __builtin_amdgcn_fence(__ATOMIC_RELEASE, "agent"); asm volatile("s_waitcnt vmcnt(0)" ::: "memory"); __hip_atomic_fetch_add(ctlw + CW_C3, 1u, RLX_AGENT); }
                if (sidx < 8 * 8) {
                    WAIT_CTR(CW_C3, (unsigned)nS);
                    bf16* const WO = WSP(bf16, WS_WO); bf16* const D2 = WSP(bf16, WS_D2);
                    pg8::Gemm g{MIX, WO + (size_t)DM * DM, MT, DM, DM}; pg8::GridOrder S; S.init(0, DM / 256, 1 << 20, sidx, 8 * 8, MP, 0, 8); S.noFull = 1;
                    pg8::EpiD E{D2};
                    pg8::gemm_phase<pg8::EpiD, pg8::GridOrder, true, true>(ldsl + RING_OFF, g, S, E);
                }
            }
        }
        {
            const fa::Geom gd{64, 0x7fffffff, (size_t)MT * 64};
            const float* const kn2f = (const float*)(ws + WS_CTL) + CW_KN2;
            const int xg = vcu >> 5;
            auto mk = [=](int stage, int n) {
                fa::BlockRef<fa::bf16_t> r;
                if (stage < 8) { if (REP_FOX) n %= 96; const int xq = (xg + stage) & 7, bh = 3 * xq + n % 3, qb = 31 - n / 3, b = bh / NHF, h = bh % NHF; const size_t row0 = (size_t)b * PT + (size_t)qb * 256;
                    r.Q = QFb + row0 * CD + h * HD; r.K = KBb + (size_t)b * PT * CD + h * HD; r.V = VBb + (size_t)b * PT * CD + h * HD; r.O = MIX + ktm((int)row0, h * HD, MT); r.G = SZFb + row0 * CD + h * HD;
                    r.bias = KBIAS + (size_t)bh * PT; r.kmax = kn2f + (size_t)bh * PT; r.P0 = qb * 256; r.skv = PT; r.nvalid = 256; r.ldq = CD; r.ldk = CD; r.ldg = CD; }
                else { const int blk = n >> 2, h = n & 3; const bool pr = blk < 64; const int row0 = pr ? blk * 256 : MP + (blk - 64) * ST, mb = pr ? (blk >> 5) : PB + (blk - 64);
                    r.Q = QMb + (size_t)row0 * MD + h * HD; r.K = MEMK + (size_t)(1 * NMB + mb) * NMEM * MD + h * HD; r.V = MEMV + (size_t)(1 * NMB + mb) * NMEM * MD + h * HD; r.O = MIX + ktm(row0, CD + h * HD, MT); r.G = SZMb + (size_t)row0 * MD + h * HD;
                    r.bias = nullptr; r.kmax = nullptr; r.P0 = 1 << 20; r.skv = NMEM; r.nvalid = pr ? 256 : ST; r.ldq = MD; r.ldk = MD; r.ldg = MD; }
                r.K2 = r.K; r.V2 = r.V; return r; };
            int stage = 0;
#define Q_CTR(st) ((unsigned*)(ctlw + rep_ * 1024 + ((st) < 8 ? CW_QFOX + 64 * ((xg + (st)) & 7) : CW_QMEM)))
#define Q_LIM(st) ((st) < 8 ? 96 * (1 + REP_FOX) : (p7in6 ? 256 : 320))
#define Q_DRAW(n_out) do { if (tid == 0) { int st_ = stage, v_ = 0; while (st_ < 9) { v_ = (int)__hip_atomic_fetch_add(Q_CTR(st_), 1u, RLX_AGENT); if (v_ < Q_LIM(st_)) break; ++st_; }                  \
                               *(volatile int*)(al + fa::LDS_QSLOT) = v_; *(volatile int*)(al + fa::LDS_QSLOT + 4) = st_; }                                                                       \
                           __syncthreads(); n_out = __builtin_amdgcn_readfirstlane(*(volatile int*)(al + fa::LDS_QSLOT)); stage = __builtin_amdgcn_readfirstlane(*(volatile int*)(al + fa::LDS_QSLOT + 4)); __syncthreads(); } while (0)
            int n_cur, n_nxt, st_cur, st_nxt;
            Q_DRAW(n_cur); st_cur = stage;
            if (st_cur < 9) {
                Q_DRAW(n_nxt); st_nxt = stage;
                if (!c2w && (st_cur == 8 || st_nxt == 8)) { WAIT_CTR(CW_C2, nC2); c2w = true; }
                fa::Seam<fa::bf16_t> Sm; fa::BlockRef<fa::bf16_t> cur = mk(st_cur, n_cur); fa::attn_prime<fa::bf16_t>(cur, gd, al, Sm);
                for (;;) {
                    const bool has_nxt = st_nxt < 9;
                    const fa::BlockRef<fa::bf16_t> nxt = has_nxt ? mk(st_nxt, n_nxt) : cur;
                    const int st_issue = stage < 9 ? stage : 8;
                    fa::attn_block<fa::bf16_t, true, fa::AtomQueue>(cur, nxt, gd, al, Sm, fa::AtomQueue{Q_CTR(st_issue)});
                    if (!has_nxt) break;
                    int n_nn = __builtin_amdgcn_readfirstlane(*(volatile int*)(al + fa::LDS_QSLOT)); int st_nn = st_issue;
                    if (stage >= 9) st_nn = 9;
                    else if (n_nn >= Q_LIM(st_issue)) { stage = st_issue + 1; __syncthreads(); Q_DRAW(n_nn); st_nn = stage; }
                    if (!c2w && st_nn == 8) { WAIT_CTR(CW_C2, nC2); c2w = true; }
                    cur = nxt; n_nxt = n_nn; st_nxt = st_nn;
                }
            }
#undef Q_DRAW
#undef Q_LIM
#undef Q_CTR
        }
#undef WAIT_CTR
        if (BOTH(6)) GRID_BAR();
    }

    REPS(7) if (IN(7)) {
        PHASE_ENV();
        bf16* const MIX = WSP(bf16, WS_MIX); bf16* const WO = WSP(bf16, WS_WO); bf16* const D2 = WSP(bf16, WS_D2);
        const bool p7in6_ = N_LAUNCHES == 1 && IN(6) && (REP_MASK & 0xe0) == 0 && ((G + 31) >> 5) * SAMPLE_CUS_PER_XCD >= 8 * 8;
        pg8::Gemm g{MIX, WO + (size_t)DM * DM, MT, DM, DM}; pg8::GridOrder S; S.init(MP / 256, DM / 256, G, bx, p7in6_ ? 0 : 8 * 8, MP, 0, 8);
        pg8::EpiD E{D2};
        pg8::gemm_phase<pg8::EpiD, pg8::GridOrder, true, true>(ldsl + RING_OFF, g, S, E);
        if (BOTH(7)) GRID_BAR();
    }

    REPS(8) if (IN(8)) {
        PHASE_ENV();
        const float* g_final = INP(19); const bf16* const XU = WSP(bf16, WS_XU); const bf16* const D2 = WSP(bf16, WS_D2);
        f32x4 gf[8];
#pragma unroll
        for (int j = 0; j < 8; ++j) gf[j] = ((const f32x4*)g_final)[64 * j + lane];
#define P8_LOAD(m_, xq, dq) do { const GAS bf16* xn_ = (const GAS bf16*)XU + ktm((m_), 4 * lane, MT); const GAS u32x2_* d2_ = (const GAS u32x2_*)(D2 + (size_t)(m_) * DM) + lane;   \
            _Pragma("unroll") for (int j = 0; j < 8; ++j) { xq[j] = *(const GAS u32x2_*)(xn_ + (size_t)(4 * j) * MT * 64); dq[j] = d2_[64 * j]; } } while (0)
        u32x2_ xa[8], da[8];
        { const int m0 = gw < MT ? gw : 0; P8_LOAD(m0, xa, da); }
        for (int m = gw; m < MT; m += NGW) {
            u32x2_ xb[8], db[8];
            { const int m2 = m + NGW < MT ? m + NGW : m; P8_LOAD(m2, xb, db); }
            GAS f32x4* xr = (GAS f32x4*)(dout + OO_Y + (size_t)m * DM) + lane;
            f32x4 v[8]; float s = 0.f;
#pragma unroll
            for (int j = 0; j < 8; ++j) { const u32x2_ a = xa[j], b = da[j]; v[j] = (f32x4){bf_lo(a.x), bf_hi(a.x), bf_lo(a.y), bf_hi(a.y)} + (f32x4){bf_lo(b.x), bf_hi(b.x), bf_lo(b.y), bf_hi(b.y)}; s += (v[j].x * v[j].x + v[j].y * v[j].y) + (v[j].z * v[j].z + v[j].w * v[j].w); }
            const float rstd = 1.0f / sqrtf(wave_sum(s) * (1.f / DM) + EPS);
#pragma unroll
            for (int j = 0; j < 8; ++j) xr[64 * j] = v[j] * rstd * gf[j];
#pragma unroll
            for (int j = 0; j < 8; ++j) { xa[j] = xb[j]; da[j] = db[j]; }
        }
#undef P8_LOAD
    }
#if defined(MFMA_PROBE_CUS)
    if (IN(8)) { GRID_BAR();
        if (bx < MFMA_PROBE_CUS) {
            typedef float f32x16_ __attribute__((ext_vector_type(16))); typedef short bf16x8_ __attribute__((ext_vector_type(8)));
            f32x16_ a0 = {}, a1 = {}, a2 = {}, a3 = {}; bf16x8_ x = {1, 2, 3, 4, 5, 6, 7, 8}, y = {8, 7, 6, 5, 4, 3, 2, 1}; asm volatile("" : "+v"(x), "+v"(y));
            for (int it = 0; it < MFMA_PROBE_N / 4; ++it) {
                a0 = __builtin_amdgcn_mfma_f32_32x32x16_bf16(x, y, a0, 0, 0, 0); a1 = __builtin_amdgcn_mfma_f32_32x32x16_bf16(x, y, a1, 0, 0, 0);
                a2 = __builtin_amdgcn_mfma_f32_32x32x16_bf16(x, y, a2, 0, 0, 0); a3 = __builtin_amdgcn_mfma_f32_32x32x16_bf16(x, y, a3, 0, 0, 0); }
            const f32x16_ s = a0 + a1 + a2 + a3; float t = 0.f;
#pragma unroll
            for (int r = 0; r < 16; ++r) t += s[r];
            if (t == 12345.678f) ((float*)(args.ws + WS_CTL))[2048] = t;
        }
    }
#endif
#undef IN
#undef BOTH
#undef GRID_BAR
}

extern "C" void kernel_launch(void* const* d_in, const int* in_sizes, int n_in, void* d_out, int out_size, void* d_ws, size_t ws_size, hipStream_t stream) {
    static int grid = 0;
    if (grid == 0) {
        if (n_in != 20 || (size_t)out_size != OUT_TOTAL || ws_size < WS_END) { fprintf(stderr, "kernel_launch: shape mismatch (n_in %d, out %d want %zu, ws %zu want %zu); nothing launched\n", n_in, out_size, (size_t)OUT_TOTAL, ws_size, (size_t)WS_END); grid = -1; return; }
        int dev = 0, cus = 0, per_cu = 0;
        if (hipGetDevice(&dev) != hipSuccess || hipDeviceGetAttribute(&cus, hipDeviceAttributeMultiprocessorCount, dev) != hipSuccess) { fprintf(stderr, "kernel_launch: device query failed\n"); grid = -1; return; }
        if (hipFuncSetAttribute((const void*)yoco_fwd, hipFuncAttributeMaxDynamicSharedMemorySize, LDS_BYTES) != hipSuccess) { fprintf(stderr, "kernel_launch: hipFuncSetAttribute failed\n"); grid = -1; return; }
        if (hipOccupancyMaxActiveBlocksPerMultiprocessor(&per_cu, (const void*)yoco_fwd, NWAVES * 64, LDS_BYTES) != hipSuccess || per_cu < 1)
            fprintf(stderr, "kernel_launch: note: occupancy query reports %d workgroups per CU\n", per_cu);
        (void)hipGetLastError();
        grid = cus;
        if (grid != 256) fprintf(stderr, "kernel_launch: note: %d CUs (the static work deals assume 256)\n", grid);
    }
    if (grid < 0) return;
    if (hipMemsetAsync((char*)d_ws + WS_CTL, 0, CTL_ZERO_BYTES, stream) != hipSuccess) { fprintf(stderr, "kernel_launch: hipMemsetAsync failed\n"); return; }
    Args a{};
    for (int i = 0; i < 20; ++i) a.in[i] = (const float*)d_in[i];
    a.out = (float*)d_out; a.ws = (unsigned char*)d_ws;
    for (int li = 0; li < N_LAUNCHES; ++li) {
        if (N_LAUNCHES == 1) { a.ph_lo = 0; a.ph_hi = N_PHASES; } else { a.ph_lo = li * N_PHASES / N_LAUNCHES; a.ph_hi = (li + 1) * N_PHASES / N_LAUNCHES; }
        hipLaunchKernelGGL(yoco_fwd, dim3(grid), dim3(NWAVES * 64), LDS_BYTES, stream, a);
        const hipError_t le = hipPeekAtLastError();
        if (le != hipSuccess) { fprintf(stderr, "kernel_launch: launch %d failed: %s\n", li, hipGetErrorName(le)); break; }
    }
}
```

```cpp
#include <hip/hip_runtime.h>
#include <cstdio>
#include <cstdint>
#ifndef MK_N_LAUNCHES
#define MK_N_LAUNCHES 1
#endif
constexpr int DM = 2048, PB = 2, PT = 8192, SB = 16, ST = 64, PAST = 4096;
constexpr int MP = PB * PT, MS = SB * ST, MT = MP + MS;
constexpr int CD = 1536, NHF = 12, HD = 128, NMEM = 256, NHM = 4, MD = 512;
constexpr int INA = 7168, INB = 4096, KVF = 3084;
constexpr int LDK = DM;
__host__ __device__ __forceinline__ size_t ktm(int row, int col, int nrows) { return ((size_t)(col >> 6) * nrows + row) * 64 + (col & 63); }
constexpr int XN_ROWS = MT + PB * NMEM, WA_ROWS = INA + 4 * MD;
constexpr int SKV_S = PAST + ST;
constexpr float EPS = 1e-6f;
constexpr int NMB = PB + SB;
constexpr size_t OO_Y = 0;
constexpr size_t OO_PSTATE = OO_Y + (size_t)MT * DM;
constexpr size_t OO_PK = OO_PSTATE + (size_t)PB * 2 * CD;
constexpr size_t OO_PV = OO_PK + (size_t)MP * CD;
constexpr size_t OO_PLOGF = OO_PV + (size_t)MP * CD;
constexpr size_t OO_PMEMK = OO_PLOGF + (size_t)MP * NHF;
constexpr size_t OO_PMEMV = OO_PMEMK + (size_t)2 * PB * NMEM * MD;
constexpr size_t OO_SSTATE = OO_PMEMV + (size_t)2 * PB * NMEM * MD;
constexpr size_t OO_SK = OO_SSTATE + (size_t)SB * 2 * CD;
constexpr size_t OO_SV = OO_SK + (size_t)MS * CD;
constexpr size_t OO_SLOGF = OO_SV + (size_t)MS * CD;
constexpr size_t OUT_TOTAL = OO_SLOGF + (size_t)MS * NHF;
constexpr size_t MiB = 1u << 20;
constexpr size_t WS_CTL = 0, CTL_ZERO_BYTES = 2 * MiB;
constexpr size_t WS_WA = 2 * MiB;
constexpr size_t WS_WB = WS_WA + 40 * MiB;
constexpr size_t WS_WO = WS_WB + 30 * MiB;
constexpr size_t WS_WF = WS_WO + 18 * MiB;
constexpr size_t WS_RS = WS_WF + 512 * 1024;
constexpr size_t WS_RS0 = WS_WF + 640 * 1024;
constexpr size_t WS_XN = WS_WF + 1 * MiB;
constexpr size_t WS_X1 = WS_XN + 75 * MiB;
constexpr size_t WS_XU = WS_X1;
constexpr size_t WS_D1 = WS_X1, WS_D2 = WS_X1 + 68 * MiB;
constexpr size_t WS_CU = WS_X1 + 136 * MiB;
constexpr size_t WS_FCU = WS_CU, WS_FBZ = WS_CU + 4 * MiB, WS_LCU = WS_CU + 8 * MiB;
constexpr size_t WS_BZ = WS_CU + 51 * MiB;
constexpr size_t WS_QM = WS_BZ + 51 * MiB;
constexpr size_t WS_SZM = WS_QM + 17 * MiB;
constexpr size_t WS_MIX = WS_SZM + 17 * MiB;
constexpr size_t WS_KB = WS_MIX + 73 * MiB;
constexpr size_t WS_VB = WS_KB + 48 * MiB;
constexpr size_t WS_QF = WS_VB + 48 * MiB;
constexpr size_t WS_SZF = WS_QF + 51 * MiB;
constexpr size_t WS_MEMK = WS_SZF + 51 * MiB;
constexpr size_t WS_MEMV = WS_MEMK + 9 * MiB;
constexpr size_t WS_KBIAS = WS_MEMV + 9 * MiB;
constexpr size_t KBIAS_S_OFF = (size_t)PB * NHF * PT;
constexpr size_t WS_END = WS_KBIAS + 4 * MiB;
static_assert(WS_END < (size_t)1536 * MiB, "d_ws map");
static_assert((size_t)(MT + 512) * LDK * 2 <= 75 * MiB && (size_t)(INA + 4 * MD) * LDK * 2 <= 40 * MiB && (size_t)INA * LDK * 2 <= 30 * MiB && (size_t)2 * DM * LDK * 2 <= 18 * MiB && (size_t)MT * LDK * 2 <= 73 * MiB && (size_t)MT * CD * 2 <= 51 * MiB && (size_t)MT * DM * 4 <= 136 * MiB && (size_t)2 * NMB * NMEM * MD * 2 <= 9 * MiB, "d_ws map sizes");
static_assert((KBIAS_S_OFF + (size_t)SB * NHF * SKV_S) * 4 <= 4 * MiB, "kbias size");
constexpr int CW_TMO = 0, CW_CODE = 1;
constexpr int CW_BAR = 4096;
constexpr int CW_C1 = 3 * 4096, CW_C2 = CW_C1 + 64, CW_C3 = CW_C1 + 128;
constexpr int CW_QFOX = 8192, CW_QMEM = CW_QFOX + 64 * 8;
constexpr int CW_SS1 = 262144 + PB * NHF * PT;
constexpr int CW_KN2 = 262144;
static_assert((size_t)(CW_SS1 + MT) * 4 <= CTL_ZERO_BYTES && CTL_ZERO_BYTES <= WS_WA, "control words inside the memset");
namespace pg8 {
#define PG8_LAS __attribute__((address_space(3)))
typedef unsigned short bf16_t;
typedef short bf16x8 __attribute__((ext_vector_type(8)));
typedef float f32x4 __attribute__((ext_vector_type(4)));
typedef unsigned u32x4 __attribute__((ext_vector_type(4)));
constexpr int BM = 256, BK = 64, HALF = 128, HTB = HALF * BK * 2  , STAGE_BYTES = 8 * HTB, NXCD = 8, WGM = 8;

__host__ __device__ __forceinline__ int lds_byte(int r, int c) { const int st = (r >> 4) * 2 + (c >> 5), rr = r & 15, cc = c & 31, ob = rr * 64 + cc * 2; return st * 1024 + (ob ^ (((ob >> 9) & 1) << 5)); }
__host__ __device__ __forceinline__ void stage_rc(int b, int& R, int& C) { const int st = b / 1024, sb = b % 1024, swz = sb ^ (((sb >> 9) & 1) << 5); R = (st >> 1) * 16 + swz / 64; C = (st & 1) * 32 + (swz % 64) / 2; }
__host__ __device__ __forceinline__ int perm32(int rho) { const int n = rho >> 4, i = rho & 15; return 8 * (i >> 2) + 4 * n + (i & 3); }

struct Unit { int row0, pn, half; };
struct Gemm { const bf16_t* A; const bf16_t* Bt; int rowsA, rowsB, K; };
__device__ __forceinline__ unsigned cvt_pk_bf16(float lo, float hi) { unsigned r; asm volatile("v_cvt_pk_bf16_f32 %0, %1, %2" : "=v"(r) : "v"(lo), "v"(hi)); return r; }
typedef float f32x2 __attribute__((ext_vector_type(2)));

struct GridOrder {
    int nM, nN, nwg, G, c; int hN0, hRow00, hPn00, hNn0, hN1, hRow01, hPn01, hNn1; int hFull;
    int noFull;
    int subBase, subN;
    int deferBase;
    __device__ __forceinline__ void init(int nM_, int nN_, int G_, int c_, int hN0_ = 0, int hRow00_ = 0, int hPn00_ = 0, int hNn0_ = 1, int hN1_ = 0, int hRow01_ = 0, int hPn01_ = 0, int hNn1_ = 1) {
        nM = nM_; nN = nN_; nwg = nM * nN; G = G_; c = c_; hN0 = hN0_; hRow00 = hRow00_; hPn00 = hPn00_; hNn0 = hNn0_; hN1 = hN1_; hRow01 = hRow01_; hPn01 = hPn01_; hNn1 = hNn1_; hFull = 0; noFull = 0; subBase = 0; subN = 0; deferBase = -1; }
    __device__ __forceinline__ bool next(int i, Unit& u) const {
        const long L = (long)i * G + c; const int nfull = noFull ? 0 : nwg; if (L >= nfull + hN0 + hN1) return false;
        const bool hf = L >= nfull;
        int e = (int)L - nfull; const bool g1 = e >= hN0; e = g1 ? e - hN0 : e;
        const bool sub = !hf && L >= subBase && L < subBase + subN;
        const bool defer = hf && g1 && deferBase >= 0;
        const int ex = sub ? (int)L - subBase : e; const bool xg1 = sub || g1;
        const int hnn = xg1 ? hNn1 : hNn0, hrow = (xg1 ? hRow01 : hRow00) + (hFull ? 256 : 128) * (ex / hnn), hpn = (xg1 ? hPn01 : hPn00) + ex % hnn;
        int wgid = defer ? deferBase + e : (hf ? 0 : (int)L); { const int q = nwg / NXCD, r = nwg % NXCD, xcd = wgid % NXCD, off = wgid / NXCD; wgid = (xcd < r ? xcd * (q + 1) : r * (q + 1) + (xcd - r) * q) + off; }
        const int nig = WGM * nN, gid = wgid / nig, fm = gid * WGM; int gsz = (nM - fm) < WGM ? (nM - fm) : WGM; gsz = gsz < 1 ? 1 : gsz;
        const int frow = (fm + ((wgid % nig) % gsz)) * BM, fpn = (wgid % nig) / gsz;
        const bool useX = (hf && !defer) || sub;
        Unit r_; r_.row0 = useX ? hrow : frow; r_.pn = useX ? hpn : fpn; r_.half = (useX && !hFull) ? 1 : 0; u = r_; return true;
    }
    __device__ __forceinline__ void a_ready(const Unit&) const {}
    __device__ __forceinline__ void done(const Unit&) const {}
};

__device__ __forceinline__ float sigmoidf_(float z) { return __builtin_amdgcn_rcpf(1.0f + __builtin_amdgcn_exp2f(-1.4426950408889634f * z)); }
__device__ __forceinline__ f32x4 silu4(f32x4 z) { return (f32x4){z[0] * sigmoidf_(z[0]), z[1] * sigmoidf_(z[1]), z[2] * sigmoidf_(z[2]), z[3] * sigmoidf_(z[3])}; }
typedef unsigned u32x2 __attribute__((ext_vector_type(2)));
__device__ __forceinline__ u32x2 pk4(f32x4 v) { u32x2 w; w.x = cvt_pk_bf16(v[0], v[1]); w.y = cvt_pk_bf16(v[2], v[3]); return w; }
__device__ __forceinline__ u32x4 pk8(f32x4 a, f32x4 b) { u32x4 w; w.x = cvt_pk_bf16(a[0], a[1]); w.y = cvt_pk_bf16(a[2], a[3]); w.z = cvt_pk_bf16(b[0], b[1]); w.w = cvt_pk_bf16(b[2], b[3]); return w; }

struct EpiA {
    static constexpr bool PERM = false, AFTER_DRAIN = false;
    bf16_t *MIXo, *QMo, *SZMo, *MEMKo, *MEMVo; float* dout; float *FCU, *FBZ, *LCU; const float* convw;
    __device__ __forceinline__ void operator()(const f32x4 (&acc)[2][2][4][2], const Unit& u, int wr, int wc, int fr, int fq) const {
        const int nai = u.half ? 1 : 2;
        if (u.pn < 24) {
            const int ch0 = u.pn * 64 + wc * 16 + fq * 4;
            const f32x4 w0 = *(const f32x4*)(convw + ch0), w1 = *(const f32x4*)(convw + CD + ch0), w2 = *(const f32x4*)(convw + 2 * CD + ch0);
#define DPP_ROR(x, n) __int_as_float(__builtin_amdgcn_mov_dpp(__float_as_int(x), 0x120 + (n), 0xf, 0xf, false))
#pragma unroll
            for (int ai = 0; ai < 2; ++ai) if (ai < nai) {
                f32x4 cu[4], bz[4];
#pragma unroll
                for (int m = 0; m < 4; ++m) { const f32x4 b = acc[ai][0][m][0], c = acc[ai][0][m][1], uu = acc[ai][1][m][0], z = acc[ai][1][m][1]; cu[m] = c * uu; bz[m] = b * silu4(z); }
                const int grow = u.row0 + ai * HALF + wr * 64, g64 = grow >> 6;
#pragma unroll
                for (int m = 0; m < 4; ++m) {
                    const int row = grow + m * 16 + fr;
                    if (row < MP) { const int t = row & (PT - 1); if (t >= PT - 2) *(f32x4*)(dout + OO_PSTATE + (size_t)((row >> 13) * 2 + (t - (PT - 2))) * CD + ch0) = cu[m]; }
                    else { const int ms = row - MP, t = ms & (ST - 1); if (t >= ST - 2) *(f32x4*)(dout + OO_SSTATE + (size_t)((ms >> 6) * 2 + (t - (ST - 2))) * CD + ch0) = cu[m]; }
                    const f32x4 pv = cu[m > 0 ? m - 1 : 0]; f32x4 a1, a2;
#pragma unroll
                    for (int e = 0; e < 4; ++e) { const float r1c = DPP_ROR(cu[m][e], 1), r1p = DPP_ROR(pv[e], 1), r2c = DPP_ROR(cu[m][e], 2), r2p = DPP_ROR(pv[e], 2);
                        a1[e] = fr >= 1 ? r1c : r1p; a2[e] = fr >= 2 ? r2c : r2p; }
                    const f32x4 o = bz[m] * (w0 * a2 + w1 * a1 + w2 * cu[m]);
                    if (m > 0 || fr >= 2) *(u32x2*)(MIXo + ktm(row, ch0, MT)) = pk4(o);
                    else { *(f32x4*)(FCU + ((size_t)g64 * 2 + fr) * CD + ch0) = cu[0]; *(f32x4*)(FBZ + ((size_t)g64 * 2 + fr) * CD + ch0) = bz[0]; }
                    if (m == 3 && fr >= 14) *(f32x4*)(LCU + ((size_t)g64 * 2 + (fr - 14)) * CD + ch0) = cu[3];
                }
            }
#undef DPP_ROR
        } else if (u.pn < 28) {
            const bool isz = u.pn >= 26; bf16_t* O = isz ? SZMo : QMo; const int col0 = ((u.pn - 24) & 1) * 256 + wc * 32 + fq * 8;
#pragma unroll
            for (int ai = 0; ai < 2; ++ai) if (ai < nai)
#pragma unroll
                for (int m = 0; m < 4; ++m) { bf16_t* rowp = O + ((size_t)u.row0 + ai * HALF + wr * 64 + m * 16 + fr) * MD + col0;
#pragma unroll
                    for (int bj = 0; bj < 2; ++bj) { f32x4 v0 = acc[ai][bj][m][0], v1 = acc[ai][bj][m][1]; if (isz) { v0 = silu4(v0); v1 = silu4(v1); }
                        *(u32x4*)(rowp + bj * HALF) = pk8(v0, v1); } }
        } else {
            const int e = u.pn - 28, layer = e >> 2, ct = e & 3; const bool isv = ct >= 2; const int col0 = (ct & 1) * 256 + wc * 32 + fq * 8;
            float* fo = dout + (isv ? OO_PMEMV : OO_PMEMK) + (size_t)layer * PB * NMEM * MD; bf16_t* ho = (isv ? MEMVo : MEMKo) + (size_t)layer * NMB * NMEM * MD;
#pragma unroll
            for (int ai = 0; ai < 2; ++ai) if (ai < nai)
#pragma unroll
                for (int m = 0; m < 4; ++m) { const size_t ro = (size_t)(u.row0 - MT + ai * HALF + wr * 64 + m * 16 + fr) * MD + col0;
#pragma unroll
                    for (int bj = 0; bj < 2; ++bj) { const f32x4 v0 = acc[ai][bj][m][0], v1 = acc[ai][bj][m][1];
                        *(f32x4*)(fo + ro + bj * HALF) = v0; *(f32x4*)(fo + ro + bj * HALF + 4) = v1; *(u32x4*)(ho + ro + bj * HALF) = pk8(v0, v1); } }
        }
    }
};
struct EpiD {
    static constexpr bool PERM = false, AFTER_DRAIN = false;
    bf16_t* O;
    __device__ __forceinline__ void operator()(const f32x4 (&acc)[2][2][4][2], const Unit& u, int wr, int wc, int fr, int fq) const {
        const int col0 = u.pn * BM + wc * 32 + fq * 8; const int nai = u.half ? 1 : 2;
#pragma unroll
        for (int ai = 0; ai < 2; ++ai) if (ai < nai)
#pragma unroll
            for (int m = 0; m < 4; ++m) { bf16_t* rowp = O + ((size_t)u.row0 + ai * HALF + wr * 64 + m * 16 + fr) * DM + col0;
#pragma unroll
                for (int bj = 0; bj < 2; ++bj) *(u32x4*)(rowp + bj * HALF) = pk8(acc[ai][bj][m][0], acc[ai][bj][m][1]); }
    }
};
struct EpiX1 {
    static constexpr bool PERM = false, AFTER_DRAIN = false;
    const bf16_t* XN0; int xn0_rows; const float* RS0; bf16_t* XU; float* SS1;
    __device__ __forceinline__ void operator()(const f32x4 (&acc)[2][2][4][2], const Unit& u, int wr, int wc, int fr, int fq) const {
        const int col0 = u.pn * BM + wc * 32 + fq * 8; const int nai = u.half ? 1 : 2;
#pragma unroll
        for (int ai = 0; ai < 2; ++ai) if (ai < nai) {
            u32x4 xw[4][2]; float ir[4];
#pragma unroll
            for (int m = 0; m < 4; ++m) { const int row = u.row0 + ai * HALF + wr * 64 + m * 16 + fr; ir[m] = RS0[row];
#pragma unroll
                for (int bj = 0; bj < 2; ++bj) xw[m][bj] = *(const u32x4*)(XN0 + ktm(row, col0 + bj * HALF, xn0_rows)); }
#pragma unroll
            for (int m = 0; m < 4; ++m) { const int row = u.row0 + ai * HALF + wr * 64 + m * 16 + fr; const float r_ = 1.0f / ir[m]; float ss = 0.f;
#pragma unroll
                for (int bj = 0; bj < 2; ++bj) { const u32x4 w = xw[m][bj];
                    const f32x4 a = (f32x4){__uint_as_float(w.x << 16), __uint_as_float(w.x & 0xffff0000u), __uint_as_float(w.y << 16), __uint_as_float(w.y & 0xffff0000u)} * r_ + acc[ai][bj][m][0];
                    const f32x4 b = (f32x4){__uint_as_float(w.z << 16), __uint_as_float(w.z & 0xffff0000u), __uint_as_float(w.w << 16), __uint_as_float(w.w & 0xffff0000u)} * r_ + acc[ai][bj][m][1];
                    ss += ((a[0] * a[0] + a[1] * a[1]) + (a[2] * a[2] + a[3] * a[3])) + ((b[0] * b[0] + b[1] * b[1]) + (b[2] * b[2] + b[3] * b[3]));
                    *(u32x4*)(XU + ktm(row, col0 + bj * HALF, MT)) = pk8(a, b); }
                ss += __shfl_xor(ss, 16); ss += __shfl_xor(ss, 32);
                if (fq == 0) atomicAdd(SS1 + row, ss); }
        }
    }
};
struct EpiB {
    static constexpr bool PERM = false, AFTER_DRAIN = false;
    unsigned char* wsb; float* dout;
    float* kn2;
    const float* ss1;
    __device__ __forceinline__ void operator()(const f32x4 (&acc)[2][2][4][2], const Unit& u, int wr, int wc, int fr, int fq) const {
        const int cin = wc * 32 + fq * 8; const int nai = u.half ? 1 : 2;
        float rsv[2][4];
#pragma unroll
        for (int ai = 0; ai < 2; ++ai)
#pragma unroll
            for (int m = 0; m < 4; ++m) rsv[ai][m] = ai < nai ? ss1[u.row0 + ai * HALF + wr * 64 + m * 16 + fr] : 0.f;
#pragma unroll
        for (int ai = 0; ai < 2; ++ai)
#pragma unroll
            for (int m = 0; m < 4; ++m) rsv[ai][m] = 1.0f / sqrtf(rsv[ai][m] * (1.0f / DM) + EPS);
        if (u.pn < 12) {
            const bool isv = u.pn >= 6; const int col0 = (u.pn - (isv ? 6 : 0)) * BM + cin; const bool pr = u.row0 < MP;
            float* fo = pr ? dout + (isv ? OO_PV : OO_PK) : dout + (isv ? OO_SV : OO_SK) - (size_t)MP * CD; bf16_t* ho = (bf16_t*)(wsb + (isv ? WS_VB : WS_KB));
#pragma unroll
            for (int ai = 0; ai < 2; ++ai) if (ai < nai)
#pragma unroll
                for (int m = 0; m < 4; ++m) { const int row_ = u.row0 + ai * HALF + wr * 64 + m * 16 + fr; const size_t ro = (size_t)row_ * CD + col0; const float rs = rsv[ai][m];
#pragma unroll
                    for (int bj = 0; bj < 2; ++bj) { const f32x4 v0 = acc[ai][bj][m][0] * rs, v1 = acc[ai][bj][m][1] * rs;
                        *(f32x4*)(fo + ro + bj * HALF) = v0; *(f32x4*)(fo + ro + bj * HALF + 4) = v1; if (pr) *(u32x4*)(ho + ro + bj * HALF) = pk8(v0, v1); } }
            if (pr && !isv) {
#pragma unroll
                for (int ai = 0; ai < 2; ++ai) if (ai < nai)
#pragma unroll
                    for (int bj = 0; bj < 2; ++bj)
#pragma unroll
                        for (int m = 0; m < 4; ++m) { const int row = u.row0 + ai * HALF + wr * 64 + m * 16 + fr, head = u.pn * 2 + bj; const float rs = rsv[ai][m];
                            const f32x4 a = acc[ai][bj][m][0] * rs, b = acc[ai][bj][m][1] * rs;
                            float ss = ((a[0] * a[0] + a[1] * a[1]) + (a[2] * a[2] + a[3] * a[3])) + ((b[0] * b[0] + b[1] * b[1]) + (b[2] * b[2] + b[3] * b[3]));
                            ss += __shfl_xor(ss, 16); ss += __shfl_xor(ss, 32);
                            if (fq == 0) atomicAdd(kn2 + (size_t)((row >> 13) * NHF + head) * PT + (row & (PT - 1)), ss); }
            }
        } else {
            size_t ob; int ld, col0; bool act;
            if (u.pn < 18) { ob = WS_QF; ld = CD; col0 = (u.pn - 12) * BM; act = false; } else if (u.pn < 24) { ob = WS_SZF; ld = CD; col0 = (u.pn - 18) * BM; act = true; }
            else if (u.pn < 26) { ob = WS_QM; ld = MD; col0 = (u.pn - 24) * BM; act = false; } else { ob = WS_SZM; ld = MD; col0 = (u.pn - 26) * BM; act = true; }
            bf16_t* O = (bf16_t*)(wsb + ob); col0 += cin;
#pragma unroll
            for (int ai = 0; ai < 2; ++ai) if (ai < nai)
#pragma unroll
                for (int m = 0; m < 4; ++m) { const int row_ = u.row0 + ai * HALF + wr * 64 + m * 16 + fr; bf16_t* rowp = O + (size_t)row_ * ld + col0; const float rs = rsv[ai][m];
#pragma unroll
                    for (int bj = 0; bj < 2; ++bj) { f32x4 v0 = acc[ai][bj][m][0] * rs, v1 = acc[ai][bj][m][1] * rs; if (act) { v0 = silu4(v0); v1 = silu4(v1); }
                        *(u32x4*)(rowp + bj * HALF) = pk8(v0, v1); } }
        }
    }
};
template <class Epi, class Sched, bool ALIGN_EPI = false, bool SP2 = false>
__device__ __forceinline__ void gemm_phase(PG8_LAS unsigned char* lds, const Gemm g, const Sched& S, const Epi& E) {
    int tid_ = threadIdx.x; asm volatile("" : "+v"(tid_));
    const int tid = tid_, wid = __builtin_amdgcn_readfirstlane(tid >> 6), lane = tid & 63, wr = wid >> 2, wc = wid & 3, fr = lane & 15, fq = lane >> 4;
    const int K = BK, nt = g.K / BK;
    unsigned voffA[2], voffB[2];
#pragma unroll
    for (int i = 0; i < 2; ++i) { int R, C; stage_rc(tid * 16 + i * 8192, R, C); const int Rb = Epi::PERM ? ((R & ~31) + perm32(R & 31)) : R;
        voffA[i] = (unsigned)(R * K + C) * 2u; voffB[i] = (unsigned)(Rb * K + C) * 2u; }
    const size_t kstepA = (size_t)g.rowsA * (BK * 2), kstepB = (size_t)g.rowsB * (BK * 2);
    const size_t hstep = (size_t)HALF * K * 2;
    const size_t tstep = 2 * hstep;
    const unsigned ldsw = (unsigned)wid * 1024u;
    const int aoff = lds_byte(wr * 64 + fr, fq * 8), boff = lds_byte(wc * 32 + fr, fq * 8);
#define PG8_SA(b, h) (((b) * 2 + (h)) * HTB)
#define PG8_SB(b, h) ((4 + (b) * 2 + (h)) * HTB)
#define PG8_STAGE(bufoff, gbase, voff) do { _Pragma("unroll") for (int _i = 0; _i < 2; ++_i) \
        __builtin_amdgcn_global_load_lds((const unsigned*)((const char*)(gbase) + (voff)[_i]), (PG8_LAS unsigned*)(lds + (bufoff) + ldsw + _i * 8192), 16, 0, 0); } while (0)
#define PG8_LDA(dst, b, h) do { _Pragma("unroll") for (int m = 0; m < 4; ++m) _Pragma("unroll") for (int k = 0; k < 2; ++k) dst[m][k] = *(const PG8_LAS bf16x8*)(lds + PG8_SA(b, h) + aoff + m * 2048 + k * 1024); } while (0)
#define PG8_LDB(dst, b, h) do { _Pragma("unroll") for (int n = 0; n < 2; ++n) _Pragma("unroll") for (int k = 0; k < 2; ++k) dst[n][k] = *(const PG8_LAS bf16x8*)(lds + PG8_SB(b, h) + boff + n * 2048 + k * 1024); } while (0)
#define PG8_MMA(ai, bj, At, Bt) do { __builtin_amdgcn_s_setprio(1); _Pragma("unroll") for (int m = 0; m < 4; ++m) _Pragma("unroll") for (int n = 0; n < 2; ++n) _Pragma("unroll") for (int k = 0; k < 2; ++k) \
        acc[ai][bj][m][n] = __builtin_amdgcn_mfma_f32_16x16x32_bf16(Bt[n][k], At[m][k], acc[ai][bj][m][n], 0, 0, 0); __builtin_amdgcn_s_setprio(0); } while (0)
#define PG8_WAIT_V(n) asm volatile("s_waitcnt vmcnt(" #n ")" ::: "memory")
#define PG8_WAIT_L(n) asm volatile("s_waitcnt lgkmcnt(" #n ")" ::: "memory")
#define PG8_BAR __builtin_amdgcn_s_barrier()
#define PG8_SCHED __builtin_amdgcn_sched_barrier(0)
    Unit cur, nxt; int ui = 0;
    if (!S.next(0, cur)) return;
    f32x4 acc[2][2][4][2];
#pragma unroll
    for (int a = 0; a < 2; ++a)
#pragma unroll
        for (int b = 0; b < 2; ++b)
#pragma unroll
            for (int m = 0; m < 4; ++m)
#pragma unroll
                for (int n = 0; n < 2; ++n) acc[a][b][m][n] = (f32x4){0.f, 0.f, 0.f, 0.f};
    bf16x8 At[4][2], B0[2][2], B1[2][2];
    const size_t rstep = (size_t)K * 2;
    const char* cA = (const char*)g.A + (size_t)cur.row0 * rstep; const char* cB = (const char*)g.Bt + (size_t)cur.pn * tstep; size_t cH = cur.half ? (size_t)0 : hstep;
    S.a_ready(cur);
    if constexpr (SP2) {
        PG8_STAGE(PG8_SB(0, 0), cB, voffB); PG8_STAGE(PG8_SB(0, 1), cB + hstep, voffB); PG8_STAGE(PG8_SA(0, 0), cA, voffA); PG8_STAGE(PG8_SA(0, 1), cA + cH, voffA);
        if (wr == 1) PG8_BAR;
        PG8_WAIT_V(2); PG8_BAR;
        PG8_STAGE(PG8_SB(1, 0), cB + kstepB, voffB); PG8_STAGE(PG8_SA(1, 0), cA + kstepA, voffA); PG8_STAGE(PG8_SB(1, 1), cB + hstep + kstepB, voffB);
        PG8_WAIT_V(6); PG8_BAR;
    } else {
        PG8_STAGE(PG8_SB(0, 0), cB, voffB); PG8_STAGE(PG8_SA(0, 0), cA, voffA); PG8_STAGE(PG8_SB(0, 1), cB + hstep, voffB); PG8_STAGE(PG8_SA(0, 1), cA + cH, voffA);
        if (wr == 1) PG8_BAR;
        PG8_WAIT_V(4); PG8_BAR;
        PG8_STAGE(PG8_SB(1, 0), cB + kstepB, voffB); PG8_STAGE(PG8_SA(1, 0), cA + kstepA, voffA); PG8_STAGE(PG8_SB(1, 1), cB + hstep + kstepB, voffB);
        PG8_WAIT_V(6); PG8_BAR;
    }
    for (;;) {
        const bool has_next = S.next(ui + 1, nxt);
        const char* nA = has_next ? (const char*)g.A + (size_t)nxt.row0 * rstep : cA; const char* nB = has_next ? (const char*)g.Bt + (size_t)nxt.pn * tstep : cB; const size_t nH = has_next ? (nxt.half ? (size_t)0 : hstep) : cH;
        for (int t = 0; t < nt; t += 2) {
            const bool last = (t == nt - 2);
            const char* a1 = cA + (size_t)(t + 1) * kstepA;
            const char* a2 = last ? nA : cA + (size_t)(t + 2) * kstepA; const char* b2 = last ? nB : cB + (size_t)(t + 2) * kstepB;
            const char* a3 = a2 + kstepA; const char* b3 = b2 + kstepB; const char* a2h = a2 + (last ? nH : cH);
            if (last && has_next) S.a_ready(nxt);
            if constexpr (SP2) {
            PG8_LDB(B0, 0, 0); PG8_LDB(B1, 0, 1); PG8_SCHED; PG8_LDA(At, 0, 0); PG8_STAGE(PG8_SA(1, 1), a1 + cH, voffA);
            PG8_WAIT_V(8); PG8_WAIT_L(0); PG8_BAR; PG8_MMA(0, 0, At, B0); PG8_MMA(0, 1, At, B1); PG8_BAR; PG8_SCHED;
            if (!cur.half) PG8_LDA(At, 0, 1); PG8_STAGE(PG8_SB(0, 0), b2, voffB); PG8_STAGE(PG8_SB(0, 1), b2 + hstep, voffB); PG8_STAGE(PG8_SA(0, 0), a2, voffA);
            PG8_WAIT_V(8); PG8_WAIT_L(0); PG8_BAR; if (!cur.half) { PG8_MMA(1, 0, At, B0); PG8_MMA(1, 1, At, B1); } PG8_BAR; PG8_SCHED;
            PG8_LDB(B0, 1, 0); PG8_LDB(B1, 1, 1); PG8_SCHED; PG8_LDA(At, 1, 0); PG8_STAGE(PG8_SA(0, 1), a2h, voffA);
            PG8_WAIT_V(8); PG8_WAIT_L(0); PG8_BAR; PG8_MMA(0, 0, At, B0); PG8_MMA(0, 1, At, B1); PG8_BAR; PG8_SCHED;
            if (!cur.half) PG8_LDA(At, 1, 1); PG8_STAGE(PG8_SB(1, 0), b3, voffB); PG8_STAGE(PG8_SB(1, 1), b3 + hstep, voffB); PG8_STAGE(PG8_SA(1, 0), a3, voffA);
            PG8_WAIT_V(8); PG8_WAIT_L(0); PG8_BAR; if (!cur.half) { PG8_MMA(1, 0, At, B0); PG8_MMA(1, 1, At, B1); } PG8_BAR; PG8_SCHED;
            } else {
            PG8_LDB(B0, 0, 0); PG8_SCHED; PG8_LDA(At, 0, 0); PG8_STAGE(PG8_SA(1, 1), a1 + cH, voffA);
            PG8_WAIT_L(8); PG8_BAR; PG8_WAIT_L(0); PG8_MMA(0, 0, At, B0); PG8_BAR; PG8_SCHED;
            PG8_LDB(B1, 0, 1); PG8_STAGE(PG8_SB(0, 0), b2, voffB);
            PG8_BAR; PG8_WAIT_L(0); PG8_MMA(0, 1, At, B1); PG8_BAR;
            PG8_LDA(At, 0, 1); PG8_STAGE(PG8_SA(0, 0), a2, voffA);
            PG8_BAR; PG8_WAIT_L(0); PG8_MMA(1, 0, At, B0); PG8_BAR; PG8_SCHED;
            PG8_STAGE(PG8_SB(0, 1), b2 + hstep, voffB);
            PG8_WAIT_V(6); PG8_BAR; PG8_MMA(1, 1, At, B1); PG8_BAR;
            PG8_LDB(B0, 1, 0); PG8_SCHED; PG8_LDA(At, 1, 0); PG8_STAGE(PG8_SA(0, 1), a2h, voffA);
            PG8_WAIT_L(8); PG8_BAR; PG8_WAIT_L(0); PG8_MMA(0, 0, At, B0); PG8_BAR; PG8_SCHED;
            PG8_LDB(B1, 1, 1); PG8_STAGE(PG8_SB(1, 0), b3, voffB);
            PG8_BAR; PG8_WAIT_L(0); PG8_MMA(0, 1, At, B1); PG8_BAR;
            PG8_LDA(At, 1, 1); PG8_STAGE(PG8_SA(1, 0), a3, voffA);
            PG8_BAR; PG8_WAIT_L(0); PG8_MMA(1, 0, At, B0); PG8_BAR; PG8_SCHED;
            PG8_STAGE(PG8_SB(1, 1), b3 + hstep, voffB);
            PG8_WAIT_V(6); PG8_BAR; PG8_MMA(1, 1, At, B1); PG8_BAR;
            }
        }
        if constexpr (ALIGN_EPI) { if (wr == 0) PG8_BAR; }
        if constexpr (!Epi::AFTER_DRAIN) { E(acc, cur, wr, wc, fr, fq); S.done(cur); }
        if (!has_next) break;
#pragma unroll
        for (int a = 0; a < 2; ++a)
#pragma unroll
            for (int b = 0; b < 2; ++b)
#pragma unroll
                for (int m = 0; m < 4; ++m)
#pragma unroll
                    for (int n = 0; n < 2; ++n) acc[a][b][m][n] = (f32x4){0.f, 0.f, 0.f, 0.f};
        cur = nxt; cA = nA; cB = nB; cH = nH; ++ui;
        if constexpr (ALIGN_EPI) { if (wr == 1) PG8_BAR; }
    }
    PG8_WAIT_V(0);
    if constexpr (!ALIGN_EPI) { if (wr == 0) PG8_BAR; }
    PG8_BAR;
    if constexpr (Epi::AFTER_DRAIN) { E.fused(acc, cur, wr, wc, fr, fq, lds, wid, lane); S.done(cur); }
#undef PG8_SA
#undef PG8_SB
#undef PG8_STAGE
#undef PG8_LDA
#undef PG8_LDB
#undef PG8_MMA
#undef PG8_WAIT_V
#undef PG8_WAIT_L
#undef PG8_BAR
#undef PG8_SCHED
}
}
namespace fa {
typedef unsigned short bf16_t;
typedef short bf16x8 __attribute__((ext_vector_type(8)));
typedef short s16x4 __attribute__((ext_vector_type(4)));
typedef float f32x16 __attribute__((ext_vector_type(16)));
typedef float f32x4 __attribute__((ext_vector_type(4)));
typedef unsigned u32x4 __attribute__((ext_vector_type(4)));
template <class A, class Bt> struct same_t { static constexpr bool v = false; };
template <class A> struct same_t<A, A> { static constexpr bool v = true; };
constexpr float SCALE = 0.08838834764831845f;
constexpr float THR = 40.f;
constexpr int D = 128, NW = 8, QBLK = 32, KVBLK = 64, QB = NW * QBLK;
constexpr int SHM_V = KVBLK * D * 2, SHM_K = KVBLK * D * 2;
constexpr int LDS_WS = 2 * SHM_V + 2 * SHM_K;
constexpr int LDS_BIAS = LDS_WS + NW * 64 * 4;
constexpr int BIAS_KEYS = 8192;
constexpr int LDS_FLAGS = LDS_BIAS + BIAS_KEYS * 4;
constexpr int LDS_QSLOT = LDS_FLAGS + 32;
constexpr int LDS_KINF = LDS_FLAGS + 64;
constexpr int LDS_BYTES = LDS_KINF + 512;
constexpr float DELTA_RAW = 28.0f / 0.08838834764831845f;
constexpr unsigned WINF = 0x40000000u;

#define KSWZ(row, colB) ((row) * 256 + ((colB) ^ (((row) & 7) << 4)))
#define SBAR() __builtin_amdgcn_sched_barrier(0)
__device__ __forceinline__ int v_st(int k, int c) { const int kk = (k & ~0xC) | ((k & 4) << 1) | ((k & 8) >> 1); return ((kk >> 3) * 4 + (c >> 5)) * 512 + ((kk & 7) * 32 + (c & 31)) * 2; }
__device__ __forceinline__ int v_rd_base(int lane) { return ((lane & 3) << 3) | (((lane >> 2) & 3) << 6) | (((lane >> 4) & 1) << 5) | (((lane >> 5) & 1) << 8); }
constexpr int v_rd_off(int d0, int ks, int half) { return d0 * 512 + ks * 4096 + half * 2048; }
__device__ __forceinline__ int crow(int r, int hi) { return (r & 3) + 8 * (r >> 2) + 4 * hi; }
__device__ __forceinline__ unsigned cvtpk(float lo, float hi) { unsigned r; asm volatile("v_cvt_pk_bf16_f32 %0, %1, %2" : "=v"(r) : "v"(lo), "v"(hi)); return r; }
__device__ __forceinline__ bf16x8 pack8(f32x4 a, f32x4 b) { u32x4 w = {cvtpk(a[0], a[1]), cvtpk(a[2], a[3]), cvtpk(b[0], b[1]), cvtpk(b[2], b[3])}; return *reinterpret_cast<bf16x8*>(&w); }
__device__ __forceinline__ bf16x8 ld8h(const bf16_t* p) { return *reinterpret_cast<const bf16x8*>(p); }
__device__ __forceinline__ void mask_tile(f32x16& p0, f32x16& p1, int dq, unsigned W) {
    const float NEG = -__builtin_inff();
#pragma unroll
    for (int r = 0; r < 16; ++r) { const int c = (r & 3) + 8 * (r >> 2);
        if ((unsigned)(dq - c) >= W) p0[r] = NEG;
        if ((unsigned)(dq - c - 32) >= W) p1[r] = NEG; }
}
__device__ __forceinline__ bool partialSM(f32x16& p0, f32x16& p1, float& m_reg, float& mn, float& alpha) {
    float pmax = p0[0]; for (int r = 1; r < 16; ++r) pmax = fmaxf(pmax, p0[r]); for (int r = 0; r < 16; ++r) pmax = fmaxf(pmax, p1[r]);
    { auto rr = __builtin_amdgcn_permlane32_swap(__float_as_uint(pmax), __float_as_uint(pmax), false, false);
      pmax = fmaxf(__uint_as_float(rr[0]), __uint_as_float(rr[1])); }
    if (__all(pmax <= m_reg - DELTA_RAW)) { mn = m_reg; alpha = 1.f; return false; }
    constexpr float C2 = 1.4426950408889634f * SCALE;
    if (__builtin_expect(__all((pmax - m_reg) * SCALE <= THR), 1)) { mn = m_reg; alpha = 1.f; }
    else { mn = fmaxf(m_reg, pmax); alpha = __builtin_amdgcn_exp2f((m_reg - mn) * C2); m_reg = mn; }
    const float mnL = -mn * C2;
    for (int r = 0; r < 16; ++r) p0[r] = fmaf(p0[r], C2, mnL); for (int r = 0; r < 16; ++r) p1[r] = fmaf(p1[r], C2, mnL);
    for (int r = 0; r < 16; ++r) p0[r] = __builtin_amdgcn_exp2f(p0[r]);
    return true;
}
__device__ __forceinline__ void finishSM(f32x16& p0, f32x16& p1, float alpha, float& l_reg, bf16x8& pa0, bf16x8& pa1, bf16x8& pa2, bf16x8& pa3) {
    for (int r = 0; r < 16; ++r) p1[r] = __builtin_amdgcn_exp2f(p1[r]);
    float ps = 0; for (int r = 0; r < 16; ++r) ps += p0[r]; for (int r = 0; r < 16; ++r) ps += p1[r];
    { auto rr = __builtin_amdgcn_permlane32_swap(__float_as_uint(ps), __float_as_uint(ps), false, false);
      ps = __uint_as_float(rr[0]) + __uint_as_float(rr[1]); }
    l_reg = l_reg * alpha + ps;
#define PK4(P, B_, OUT) do { unsigned a0 = cvtpk(P[B_+0], P[B_+1]), a1 = cvtpk(P[B_+2], P[B_+3]);                          \
        unsigned b0 = cvtpk(P[B_+4], P[B_+5]), b1 = cvtpk(P[B_+6], P[B_+7]);                                             \
        auto r0 = __builtin_amdgcn_permlane32_swap(a0, b0, false, false); auto r1 = __builtin_amdgcn_permlane32_swap(a1, b1, false, false); \
        u32x4 w = {r0[0], r1[0], r0[1], r1[1]}; OUT = *reinterpret_cast<bf16x8*>(&w); } while (0)
    PK4(p0, 0, pa0); PK4(p0, 8, pa1); PK4(p1, 0, pa2); PK4(p1, 8, pa3);
#undef PK4
}
template <int KB>
__device__ __forceinline__ void qkt(f32x16& p0, f32x16& p1, const char* K_lds, const char* bl, int r32, int hi, const bf16x8* qr) {
#pragma unroll
    for (int j = 0; j < 4; ++j) { const f32x4 a = *reinterpret_cast<const f32x4*>(bl + 32 * j), b = *reinterpret_cast<const f32x4*>(bl + 128 + 32 * j);
        p0[4 * j] = a[0]; p0[4 * j + 1] = a[1]; p0[4 * j + 2] = a[2]; p0[4 * j + 3] = a[3]; p1[4 * j] = b[0]; p1[4 * j + 1] = b[1]; p1[4 * j + 2] = b[2]; p1[4 * j + 3] = b[3]; }
    const char* kb[4];
#pragma unroll
    for (int dd = 0; dd < 4; ++dd) kb[dd] = K_lds + KB * SHM_K + KSWZ(r32, (dd * 16 + hi * 8) * 2);
#pragma unroll
    for (int d0 = 0; d0 < 8; ++d0) { const char* a = kb[d0 & 3] + (d0 >> 2) * 128;
        bf16x8 b0 = *reinterpret_cast<const bf16x8*>(a);
        bf16x8 b1 = *reinterpret_cast<const bf16x8*>(a + 32 * 256);
        p0 = __builtin_amdgcn_mfma_f32_32x32x16_bf16(b0, qr[d0], p0, 0, 0, 0);
        p1 = __builtin_amdgcn_mfma_f32_32x32x16_bf16(b1, qr[d0], p1, 0, 0, 0); }
}
template <int VB>
__device__ __forceinline__ void pv_tile(f32x16* o, int vb0, bf16x8 pa0, bf16x8 pa1, bf16x8 pa2, bf16x8 pa3) {
#define TRRD(dst, off) asm volatile("ds_read_b64_tr_b16 %0, %1 offset:%2" : "=&v"(dst) : "v"(vb0), "i"(off) : "memory")
#define PV_D0(d0) do { s16x4 l0, l1, l2, l3, h0, h1, h2, h3; constexpr int b_ = VB * SHM_V + v_rd_off(d0, 0, 0);     \
        TRRD(l0, b_); TRRD(h0, b_ + 2048); TRRD(l1, b_ + 4096); TRRD(h1, b_ + 6144); TRRD(l2, b_ + 8192); TRRD(h2, b_ + 10240); TRRD(l3, b_ + 12288); TRRD(h3, b_ + 14336); \
        asm volatile("s_waitcnt lgkmcnt(0)" ::: "memory"); SBAR();                 \
        o[d0] = __builtin_amdgcn_mfma_f32_32x32x16_bf16(pa0, (bf16x8){l0[0], l0[1], l0[2], l0[3], h0[0], h0[1], h0[2], h0[3]}, o[d0], 0, 0, 0);   \
        o[d0] = __builtin_amdgcn_mfma_f32_32x32x16_bf16(pa1, (bf16x8){l1[0], l1[1], l1[2], l1[3], h1[0], h1[1], h1[2], h1[3]}, o[d0], 0, 0, 0);   \
        o[d0] = __builtin_amdgcn_mfma_f32_32x32x16_bf16(pa2, (bf16x8){l2[0], l2[1], l2[2], l2[3], h2[0], h2[1], h2[2], h2[3]}, o[d0], 0, 0, 0);   \
        o[d0] = __builtin_amdgcn_mfma_f32_32x32x16_bf16(pa3, (bf16x8){l3[0], l3[1], l3[2], l3[3], h3[0], h3[1], h3[2], h3[3]}, o[d0], 0, 0, 0); } while (0)
    PV_D0(0); PV_D0(1); PV_D0(2); PV_D0(3);
#undef PV_D0
#undef TRRD
}

template <class TKV> struct BlockRef { const bf16_t* Q; const TKV* K; const TKV* V; const TKV* K2; const TKV* V2; bf16_t* O; const bf16_t* G; const float* bias; const float* kmax; int P0, skv, nvalid, ldq, ldk, ldg; };
template <class TKV> __device__ __forceinline__ int n_tiles(const BlockRef<TKV>& b) { int j = (b.P0 + QB - 1) / KVBLK + 1; const int m = b.skv / KVBLK; return j > m ? m : j; }
struct NoQueue { __device__ __forceinline__ int issue(int) const { return 0; } __device__ __forceinline__ void publish(int, int, char*) const {} };
struct AtomQueue { unsigned* ctr;
    __device__ __forceinline__ int issue(int tid) const { int v = 0; if (tid == 0) v = (int)__hip_atomic_fetch_add(ctr, 1u, __ATOMIC_RELAXED, __HIP_MEMORY_SCOPE_AGENT); return v; }
    __device__ __forceinline__ void publish(int v, int tid, char* lds) const { if (tid == 0) *(volatile int*)(lds + LDS_QSLOT) = v; } };
struct Geom { int ldo, ksplit; size_t sdo; };
template <class T> __device__ __forceinline__ const T* rowp(const T* base, int k0, int ldk, unsigned lane_elem_off) { return (const T*)((const char*)(base + (size_t)k0 * ldk) + lane_elem_off * (unsigned)sizeof(T)); }
template <class TKV> struct Seam { bf16x8 qr[8]; bf16x8 st_v0, st_v1, st_k0, st_k1; f32x4 sf0, sf1, sf2, sf3, sg0, sg1, sg2, sg3; };

#define ROW(p, k0, rr) rowp(p, k0, ldk_, (unsigned)((rr) * ldk_ + sc))
#define KSEL(B_, k0) (((k0) >= g.ksplit) ? (B_).K2 : (B_).K)
#define VSEL(B_, k0) (((k0) >= g.ksplit) ? (B_).V2 : (B_).V)
#define VMW() asm volatile("s_waitcnt vmcnt(0)" ::: "memory")
#define VMWN(n) asm volatile("s_waitcnt vmcnt(%0)" :: "i"(n) : "memory")
#define SLOAD_H(Kp, Vp, k0) do { S.st_v0 = ld8h((const bf16_t*)ROW(Vp, k0, sr)); S.st_v1 = ld8h((const bf16_t*)ROW(Vp, k0, 32 + sr));              \
                         S.st_k0 = ld8h((const bf16_t*)ROW(Kp, k0, sr)); S.st_k1 = ld8h((const bf16_t*)ROW(Kp, k0, 32 + sr)); } while (0)
#define SWRITE_HK(bf) do { *(bf16x8*)(K_lds + (bf) * SHM_K + kws) = S.st_k0; *(bf16x8*)(K_lds + (bf) * SHM_K + kws + 32 * 256) = S.st_k1; } while (0)
#define SWRITE_HV(bf) do { *(bf16x8*)(V_lds + (bf) * SHM_V + vst0) = S.st_v0; *(bf16x8*)(V_lds + (bf) * SHM_V + vst1) = S.st_v1; } while (0)
#define SWRITE_H(bf) do { SWRITE_HV(bf); SWRITE_HK(bf); } while (0)
#define SLOAD_F(p, k0) do { S.sf0 = *(const f32x4*)ROW(p, k0, sr); S.sf1 = *(const f32x4*)(ROW(p, k0, sr) + 4);                \
                            S.sf2 = *(const f32x4*)ROW(p, k0, 32 + sr); S.sf3 = *(const f32x4*)(ROW(p, k0, 32 + sr) + 4); } while (0)
#define SWRITE_KF(bf) do { *(bf16x8*)(K_lds + (bf) * SHM_K + kws) = pack8(S.sf0, S.sf1); *(bf16x8*)(K_lds + (bf) * SHM_K + kws + 32 * 256) = pack8(S.sf2, S.sf3); } while (0)
#define SLOAD_G(p, k0) do { S.sg0 = *(const f32x4*)ROW(p, k0, sr); S.sg1 = *(const f32x4*)(ROW(p, k0, sr) + 4);                \
                            S.sg2 = *(const f32x4*)ROW(p, k0, 32 + sr); S.sg3 = *(const f32x4*)(ROW(p, k0, 32 + sr) + 4); } while (0)
#define SWRITE_VF(bf) do { *(bf16x8*)(V_lds + (bf) * SHM_V + vst0) = pack8(S.sg0, S.sg1); *(bf16x8*)(V_lds + (bf) * SHM_V + vst1) = pack8(S.sg2, S.sg3); } while (0)
#define QROWP(B_) ((B_).Q + (size_t)((wid * QBLK + r32) & ((B_).nvalid - 1)) * (B_).ldq + hi * 8)
template <class TKV>
__device__ __forceinline__ void attn_prime(const BlockRef<TKV>& cur, const Geom g, char* lds, Seam<TKV>& S) {
    constexpr bool F32 = same_t<TKV, float>::v;
    int tid_ = threadIdx.x; asm volatile("" : "+v"(tid_));
    const int tid = tid_, wid = __builtin_amdgcn_readfirstlane(tid >> 6), lane = tid & 63, r32 = lane & 31, hi = lane >> 5;
    const int sr = tid >> 4, sc = (tid & 15) * 8, kws = KSWZ(sr, sc * 2); char* K_lds = lds + 2 * SHM_V;
    { const bf16_t* qp = QROWP(cur);
#pragma unroll
      for (int d0 = 0; d0 < 8; ++d0) S.qr[d0] = ld8h(qp + d0 * 16); }
    const int kb0 = (n_tiles(cur) - 1) * KVBLK, ldk_ = cur.ldk;
    if constexpr (F32) { SLOAD_F((const float*)KSEL(cur, kb0), kb0); VMW(); SWRITE_KF(0); SBAR(); SLOAD_G((const float*)VSEL(cur, kb0), kb0); }
    else { SLOAD_H(KSEL(cur, kb0), VSEL(cur, kb0), kb0); VMW(); SWRITE_HK(0); }
    __syncthreads();
}
template <class TKV, bool SKIP, class QH>
__device__ __forceinline__ void attn_block(const BlockRef<TKV>& cur, const BlockRef<TKV>& nxt, const Geom g, char* lds, Seam<TKV>& S, const QH& qh) {
    constexpr bool F32 = same_t<TKV, float>::v;
    int tid_ = threadIdx.x; asm volatile("" : "+v"(tid_));
    const int tid = tid_, wid = __builtin_amdgcn_readfirstlane(tid >> 6), lane = tid & 63, r32 = lane & 31, hi = lane >> 5;
    const int NTT = n_tiles(cur); int NT = NTT;
    const int kbn = (n_tiles(nxt) - 1) * KVBLK; int ldk_ = cur.ldk;
    const int qlo = cur.P0 + wid * QBLK, qm = qlo + r32 - 4 * hi;
    const bool wact = !F32 || wid * QBLK < cur.nvalid;
    char* V_lds = lds; char* K_lds = lds + 2 * SHM_V;
    float* ws = (float*)(lds + LDS_WS) + wid * 64; float* li_l = ws, * al_l = ws + 32;
    const char* bl = lds + LDS_BIAS + hi * 16;
    float m_reg = -1e30f, l_reg = 0; f32x16 o[4] = {};
    const int sr = tid >> 4, sc = (tid & 15) * 8, vst0 = v_st(sr, sc), vst1 = v_st(32 + sr, sc), kws = KSWZ(sr, sc * 2);
    const int vb0 = (int)(uintptr_t)V_lds + v_rd_base(lane);
    { f32x4* bdst = (f32x4*)(lds + LDS_BIAS);
      if (cur.bias) { const f32x4* bsrc = (const f32x4*)cur.bias; f32x4 bt[4];
#pragma unroll
          for (int j = 0; j < 4; ++j) { const int i = tid + j * NW * 64; if (i < NTT * 16) bt[j] = bsrc[i]; }
#pragma unroll
          for (int j = 0; j < 4; ++j) { const int i = tid + j * NW * 64; if (i < NTT * 16) bdst[i] = bt[j]; } }
      else { f32x4 z = {0.f, 0.f, 0.f, 0.f}; asm volatile("" : "+v"(z));
             for (int i = tid; i < NTT * 16; i += NW * 64) bdst[i] = z; } }
    const bool doskip = SKIP && cur.kmax != nullptr;
    if constexpr (SKIP) { if (doskip) {
        float v = 0.f;
        if (tid < NTT * 4) { const f32x4* kp = (const f32x4*)(cur.kmax + 16 * tid); const f32x4 a = kp[0], b = kp[1], c = kp[2], d = kp[3];
            v = fmaxf(fmaxf(fmaxf(fmaxf(a[0], a[1]), fmaxf(a[2], a[3])), fmaxf(fmaxf(b[0], b[1]), fmaxf(b[2], b[3]))), fmaxf(fmaxf(fmaxf(c[0], c[1]), fmaxf(c[2], c[3])), fmaxf(fmaxf(d[0], d[1]), fmaxf(d[2], d[3])))); }
        v = fmaxf(v, __int_as_float(__builtin_amdgcn_ds_bpermute((lane ^ 1) << 2, __float_as_int(v)))); v = fmaxf(v, __int_as_float(__builtin_amdgcn_ds_bpermute((lane ^ 2) << 2, __float_as_int(v))));
        if ((tid & 3) == 0 && tid < NTT * 4) ((float*)(lds + LDS_KINF))[tid >> 2] = v;
    } }
    __syncthreads();
    if constexpr (SKIP) { if (doskip) {
        if (wid == 0) { float* kinf = (float*)(lds + LDS_KINF); float a = lane < NTT ? kinf[lane] : 0.f, b = 64 + lane < NTT ? kinf[64 + lane] : 0.f;
#pragma unroll
            for (int o = 1; o < 64; o <<= 1) { const int src = ((lane - o) & 63) << 2;
                const float na = __int_as_float(__builtin_amdgcn_ds_bpermute(src, __float_as_int(a))), nb = __int_as_float(__builtin_amdgcn_ds_bpermute(src, __float_as_int(b)));
                if (lane >= o) { a = fmaxf(a, na); b = fmaxf(b, nb); } }
            b = fmaxf(b, __int_as_float(__builtin_amdgcn_ds_bpermute((63 + 0 * lane) << 2, __float_as_int(a))));
            kinf[lane] = sqrtf(a) * 1.004f; kinf[64 + lane] = sqrtf(b) * 1.004f; }
        float qn1 = 0.f;
#pragma unroll
        for (int d0 = 0; d0 < 8; ++d0) { const u32x4 w = __builtin_bit_cast(u32x4, S.qr[d0]);
#define SQ2(x) (__uint_as_float((x) << 16) * __uint_as_float((x) << 16) + __uint_as_float((x) & 0xffff0000u) * __uint_as_float((x) & 0xffff0000u))
            qn1 += (SQ2(w.x) + SQ2(w.y)) + (SQ2(w.z) + SQ2(w.w)); }
#undef SQ2
        { auto rr = __builtin_amdgcn_permlane32_swap(__float_as_uint(qn1), __float_as_uint(qn1), false, false); qn1 = __uint_as_float(rr[0]) + __uint_as_float(rr[1]); }
        if (hi == 0) li_l[r32] = sqrtf(qn1) * 1.0001f;
    } }
    __syncthreads();
#define RESC(a) do { if (__any((a) < 1.f)) { if (hi == 0) al_l[r32] = (a); asm volatile("s_waitcnt lgkmcnt(0)" ::: "memory");              \
                     for (int d_ = 0; d_ < 4; ++d_) for (int r = 0; r < 16; ++r) o[d_][r] *= al_l[crow(r, hi)]; } } while (0)
#define KBASE(t) ((NTT - 1 - (t)) * KVBLK)
#define MASKT(P0_, P1_, t) do { const int kb_ = KBASE(t); if (kb_ + KVBLK - 1 > qlo) mask_tile(P0_, P1_, qm - kb_, WINF); } while (0)
    constexpr int NQL = 8;
#define SEAM_K0() do { VMWN(NQL); if constexpr (F32) { SWRITE_KF(0); SBAR(); SLOAD_G((const float*)VSEL(nxt, kbn), kbn); } else { SWRITE_HK(0); } SBAR(); } while (0)
    f32x16 pA0, pA1, pB0, pB1; float mnA, mnB, alA, alB; bf16x8 pa0, pa1, pa2, pa3;
    if constexpr (F32) { VMW(); SWRITE_VF(0); SBAR(); } else { SWRITE_HV(0); SBAR(); }
    if (NT > 1) { if constexpr (F32) { SLOAD_F((const float*)KSEL(cur, KBASE(1)), KBASE(1)); SBAR(); SLOAD_G((const float*)VSEL(cur, KBASE(1)), KBASE(1)); } else SLOAD_H(KSEL(cur, KBASE(1)), VSEL(cur, KBASE(1)), KBASE(1)); }
#define LIVE0(t) (wact && !(KBASE(t) > qlo + QBLK - 1))
    bool lvA = LIVE0(0), lvB = false;
    SBAR(); if (lvA) qkt<0>(pA0, pA1, K_lds, bl + KBASE(0) * 4, r32, hi, S.qr);
    if constexpr (F32) { if (NT > 1) { VMWN(4); SWRITE_KF(1); SBAR(); } }
    if (lvA) { MASKT(pA0, pA1, 0); lvA = partialSM(pA0, pA1, m_reg, mnA, alA); }
    if (NT > 1) { VMW(); if constexpr (F32) { SWRITE_VF(1); SBAR(); if (NT > 2) { SLOAD_F((const float*)KSEL(cur, KBASE(2)), KBASE(2)); SBAR(); SLOAD_G((const float*)VSEL(cur, KBASE(2)), KBASE(2)); } } else SWRITE_H(1); }
    __syncthreads();
#define HALF_STEP(PX0, PX1, mnX, alX, PY0, PY1, alY, t, KB, VB, SB, VOTE, LX, LY) do {                                                      \
        SBAR(); if constexpr (!F32) { if ((t) + 1 < NT) { SLOAD_H(KSEL(cur, KBASE((t) + 1)), VSEL(cur, KBASE((t) + 1)), KBASE((t) + 1)); } SBAR(); }     \
        LX = LIVE0(t); if (LX) qkt<KB>(PX0, PX1, K_lds, bl + KBASE(t) * 4, r32, hi, S.qr);                                   \
        if (LY) finishSM(PY0, PY1, alY, l_reg, pa0, pa1, pa2, pa3); SBAR();                                                         \
        if ((t) + 1 < NT) { if constexpr (F32) { VMWN(4); SWRITE_KF(SB); SBAR(); } }                                         \
        if (LY) pv_tile<VB>(o, vb0, pa0, pa1, pa2, pa3); if (LX) { MASKT(PX0, PX1, (t)); LX = partialSM(PX0, PX1, m_reg, mnX, alX); }   \
        __syncthreads();                                                                                                      \
        if ((t) + 1 < NT) { VMW(); if constexpr (F32) { SWRITE_VF(SB); SBAR(); if ((t) + 2 < NT) { SLOAD_F((const float*)KSEL(cur, KBASE((t) + 2)), KBASE((t) + 2)); SBAR(); SLOAD_G((const float*)VSEL(cur, KBASE((t) + 2)), KBASE((t) + 2)); } } \
                            else { SWRITE_H(SB); } }                                                                          \
        if constexpr (SKIP && (VOTE)) { if (doskip) { const int tk = NTT - 2 - (t); bool ok = true;     \
            if (tk >= 0) { const float ub = li_l[r32] * ((const float*)(lds + LDS_KINF))[tk] + ((const float*)(lds + LDS_BIAS))[64 * tk + 63]; ok = ub <= m_reg - DELTA_RAW; }              \
            const bool okw = __all(ok); if (lane == 0) ((volatile unsigned*)(lds + LDS_FLAGS))[wid] = okw ? 1u : 0u; } }                                                     \
        if (LX) { RESC(alX); } __syncthreads(); } while (0)
    for (int t = 1; t + 1 < NT; t += 2) {
        HALF_STEP(pB0, pB1, mnB, alB, pA0, pA1, alA, t, 1, 0, 0, false, lvB, lvA);
        HALF_STEP(pA0, pA1, mnA, alA, pB0, pB1, alB, t + 1, 0, 1, 1, true, lvA, lvB);
        if constexpr (SKIP) { if (doskip) { const u32x4 f0 = *(const u32x4*)(lds + LDS_FLAGS), f1 = *(const u32x4*)(lds + LDS_FLAGS + 16);
            if (__builtin_amdgcn_readfirstlane(f0.x & f0.y & f0.z & f0.w & f1.x & f1.y & f1.z & f1.w) != 0u) { NT = t + 2; break; } } }
    }
    const bool even = (NT & 1) == 0;
    if (even) { SBAR(); lvB = LIVE0(NT - 1); if (lvB) qkt<1>(pB0, pB1, K_lds, bl + KBASE(NT - 1) * 4, r32, hi, S.qr); SBAR(); }
    ldk_ = nxt.ldk;
    if constexpr (F32) { SLOAD_F((const float*)KSEL(nxt, kbn), kbn); SBAR(); } else { SLOAD_H(KSEL(nxt, kbn), VSEL(nxt, kbn), kbn); SBAR(); }
    { const bf16_t* qp = QROWP(nxt);
#pragma unroll
      for (int d0 = 0; d0 < 8; ++d0) S.qr[d0] = ld8h(qp + d0 * 16); }
    SBAR();
    if (lvA) { finishSM(pA0, pA1, alA, l_reg, pa0, pa1, pa2, pa3); SBAR();
    pv_tile<0>(o, vb0, pa0, pa1, pa2, pa3); }
    if (even) { if (lvB) { MASKT(pB0, pB1, NT - 1); lvB = partialSM(pB0, pB1, m_reg, mnB, alB); } __syncthreads(); if (lvB) { RESC(alB);
        finishSM(pB0, pB1, alB, l_reg, pa0, pa1, pa2, pa3); SBAR(); pv_tile<1>(o, vb0, pa0, pa1, pa2, pa3); } }
    SBAR(); SEAM_K0();
    const int qv = qh.issue(tid);
    if (hi == 0) li_l[r32] = l_reg; asm volatile("s_waitcnt lgkmcnt(0)" ::: "memory");
    if (wid * QBLK < cur.nvalid) {
        float rli[16];
#pragma unroll
        for (int r = 0; r < 16; ++r) rli[r] = __builtin_amdgcn_rcpf(li_l[crow(r, hi)]);
        typedef __attribute__((address_space(1))) bf16_t gbf16_t;
        gbf16_t* Ow = (gbf16_t*)(cur.O + (size_t)(wid * QBLK + 4 * hi) * g.ldo + r32); const gbf16_t* Gw = (const gbf16_t*)(cur.G + (size_t)(wid * QBLK + 4 * hi) * cur.ldg + r32);
        asm volatile("" : "+v"(Ow), "+v"(Gw));
        unsigned short gq[16][4];
#pragma unroll
        for (int r = 0; r < 16; ++r) { const int orow = (r & 3) + 8 * (r >> 2);
#pragma unroll
            for (int d0 = 0; d0 < 4; ++d0) gq[r][d0] = Gw[(size_t)orow * cur.ldg + d0 * 32]; }
        SBAR();
#pragma unroll
        for (int r = 0; r < 16; ++r) { const int orow = (r & 3) + 8 * (r >> 2);
#pragma unroll
            for (int d0 = 0; d0 < 4; ++d0) { const float v = o[d0][r] * rli[r] * __uint_as_float((unsigned)gq[r][d0] << 16); Ow[(size_t)orow * g.ldo + (size_t)(d0 >> 1) * g.sdo + (d0 & 1) * 32] = (bf16_t)(cvtpk(v, v) & 0xffffu); } }
    }
    qh.publish(qv, tid, lds);
    __syncthreads();
#undef RESC
#undef LIVE0
#undef KBASE
#undef MASKT
#undef SEAM_K0
#undef HALF_STEP
}
__device__ __forceinline__ void sample_unit(const BlockRef<float>& cur, const Geom g, char* lds) {
    int tid_ = threadIdx.x; asm volatile("" : "+v"(tid_));
    const int tid = tid_, wid = __builtin_amdgcn_readfirstlane(tid >> 6), lane = tid & 63, r32 = lane & 31, hi = lane >> 5;
    const int NTT = n_tiles(cur), NT = NTT;
    char* V_lds = lds; char* K_lds = lds + 2 * SHM_V;
    float* const kx = (float*)(lds + LDS_BIAS) + 4224;
    float* const kpart = kx; float* const kinf = kx + 256; volatile unsigned* const votes = (volatile unsigned*)(kx + 384);
    { f32x4* bdst = (f32x4*)(lds + LDS_BIAS); const f32x4* bsrc = (const f32x4*)cur.bias; f32x4 bt[4];
#pragma unroll
      for (int j = 0; j < 4; ++j) { const int i = tid + j * NW * 64; if (i < NTT * 16) bt[j] = bsrc[i]; }
#pragma unroll
      for (int j = 0; j < 4; ++j) { const int i = tid + j * NW * 64; if (i < NTT * 16) bdst[i] = bt[j]; } }
    if (tid < 4) votes[tid] = 0u;
#define KBASE(t) ((NTT - 1 - (t)) * KVBLK)
#define SU_EXIT(t) ((t) >= 1 && __builtin_amdgcn_readfirstlane(votes[(((t) - 1) & 1) * 2] & votes[(((t) - 1) & 1) * 2 + 1]) != 0u)
    const int lt = (wid & 1) * 64 + lane, key0 = lt >> 4, sc = (lt & 15) * 8; const int ldk_ = cur.ldk;
#define SU_LOADX(dst, P_, t_) do { const int kb_ = KBASE(t_); const float* Xp_ = P_(cur, kb_);                                                                                                    \
            _Pragma("unroll") for (int i = 0; i < 8; ++i) { const float* xr_ = rowp(Xp_, kb_, ldk_, (unsigned)((i * 8 + key0) * ldk_ + sc)); dst[i][0] = *(const f32x4*)xr_; dst[i][1] = *(const f32x4*)(xr_ + 4); } } while (0)
#define SU_NORM(src, t_) do { float mx_ = 0.f;                                                                                                                                                  \
            _Pragma("unroll") for (int i = 0; i < 8; ++i) { const f32x4 a_ = src[i][0], b_ = src[i][1];                                                                                          \
                float s_ = ((a_[0] * a_[0] + a_[1] * a_[1]) + (a_[2] * a_[2] + a_[3] * a_[3])) + ((b_[0] * b_[0] + b_[1] * b_[1]) + (b_[2] * b_[2] + b_[3] * b_[3]));                            \
                s_ += __shfl_xor(s_, 1); s_ += __shfl_xor(s_, 2); s_ += __shfl_xor(s_, 4); s_ += __shfl_xor(s_, 8); mx_ = fmaxf(mx_, s_); }                              \
            mx_ = fmaxf(mx_, __shfl_xor(mx_, 16)); mx_ = fmaxf(mx_, __shfl_xor(mx_, 32)); if (lane == 0) kpart[(t_) * 2 + (wid & 1)] = mx_; } while (0)
    { f32x4 xa[8][2], xb[8][2], xc[8][2]; const int ps = wid >> 1; int t0 = ps, t1 = ps + 4, t2 = ps + 8;
      if (t0 < NT) SU_LOADX(xa, KSEL, t0);
      if (t1 < NT) SU_LOADX(xb, KSEL, t1);
      if (t2 < NT) SU_LOADX(xc, KSEL, t2);
      while (t0 < NT) {
          SU_NORM(xa, t0); t0 += 12; if (t0 < NT) SU_LOADX(xa, KSEL, t0);
          if (t1 < NT) { SU_NORM(xb, t1); t1 += 12; if (t1 < NT) SU_LOADX(xb, KSEL, t1); }
          if (t2 < NT) { SU_NORM(xc, t2); t2 += 12; if (t2 < NT) SU_LOADX(xc, KSEL, t2); }
      } }
    if (wid >= 2) {
        f32x4 ka[8][2], va[8][2];
        const int gl = (wid - 2) >> 1;
        int tl = gl;
        if (tl < NT) { SU_LOADX(ka, KSEL, tl); SU_LOADX(va, VSEL, tl); }
        __syncthreads();
        if (wid == 2) {
            float a = lane < NT ? fmaxf(kpart[2 * lane], kpart[2 * lane + 1]) : 0.f, b = 64 + lane < NT ? fmaxf(kpart[128 + 2 * lane], kpart[129 + 2 * lane]) : 0.f;
#pragma unroll
            for (int o = 1; o < 64; o <<= 1) { const float na = __shfl_down(a, o), nb = __shfl_down(b, o); if (lane + o < 64) { a = fmaxf(a, na); b = fmaxf(b, nb); } }
            a = fmaxf(a, __shfl(b, 0));
            kinf[lane] = sqrtf(a) * 1.004f; kinf[64 + lane] = sqrtf(b) * 1.004f;
        }
        __syncthreads();
        for (int t = 0; t < NT; ++t) {
            if (t == tl) {
                const int bf = t & 1;
#pragma unroll
                for (int i = 0; i < 8; ++i) *(bf16x8*)(K_lds + bf * SHM_K + KSWZ(i * 8 + key0, sc * 2)) = pack8(ka[i][0], ka[i][1]);
#pragma unroll
                for (int i = 0; i < 8; ++i) *(bf16x8*)(V_lds + bf * SHM_V + v_st(i * 8 + key0, sc)) = pack8(va[i][0], va[i][1]);
                tl += 3; if (tl < NT) { SU_LOADX(ka, KSEL, tl); SU_LOADX(va, VSEL, tl); }
            }
            __syncthreads();
            if (SU_EXIT(t)) break;
        }
#undef SU_LOADX
#undef SU_NORM
    } else {
        float* ws = (float*)(lds + LDS_WS) + wid * 64; float* li_l = ws, * al_l = ws + 32;
        const char* bl = lds + LDS_BIAS + hi * 16;
        const int qlo = cur.P0 + wid * QBLK, qm = qlo + r32 - 4 * hi;
        const int vb0 = (int)(uintptr_t)V_lds + v_rd_base(lane);
        bf16x8 qr[8];
        { const bf16_t* qp = QROWP(cur);
#pragma unroll
          for (int d0 = 0; d0 < 8; ++d0) qr[d0] = ld8h(qp + d0 * 16); }
        float qn = 0.f;
#pragma unroll
        for (int d0 = 0; d0 < 8; ++d0) { const u32x4 w = __builtin_bit_cast(u32x4, qr[d0]);
#define SQ2(x) (__uint_as_float((x) << 16) * __uint_as_float((x) << 16) + __uint_as_float((x) & 0xffff0000u) * __uint_as_float((x) & 0xffff0000u))
            qn += (SQ2(w.x) + SQ2(w.y)) + (SQ2(w.z) + SQ2(w.w)); }
#undef SQ2
        { auto rr = __builtin_amdgcn_permlane32_swap(__float_as_uint(qn), __float_as_uint(qn), false, false); qn = sqrtf(__uint_as_float(rr[0]) + __uint_as_float(rr[1])) * 1.0001f; }
        float m_reg = -1e30f, l_reg = 0; f32x16 o[4] = {};
        __syncthreads();
        __syncthreads();
        f32x16 p0, p1; float mn, al; bf16x8 pa0, pa1, pa2, pa3;
#define SU_RESC(a) do { if (__any((a) < 1.f)) { if (hi == 0) al_l[r32] = (a); asm volatile("s_waitcnt lgkmcnt(0)" ::: "memory");              \
                     for (int d_ = 0; d_ < 4; ++d_) for (int r = 0; r < 16; ++r) o[d_][r] *= al_l[crow(r, hi)]; } } while (0)
#define SU_BODY(KB, t) do { SBAR(); qkt<KB>(p0, p1, K_lds, bl + KBASE(t) * 4, r32, hi, qr);                                                      \
            { const int kb_ = KBASE(t); if (kb_ + KVBLK - 1 > qlo) mask_tile(p0, p1, qm - kb_, WINF); }                                        \
            if (partialSM(p0, p1, m_reg, mn, al)) { SU_RESC(al); finishSM(p0, p1, al, l_reg, pa0, pa1, pa2, pa3); SBAR();       \
            pv_tile<KB>(o, vb0, pa0, pa1, pa2, pa3); } SBAR(); } while (0)
        for (int t = 0; t < NT; ++t) {
            __syncthreads();
            if (SU_EXIT(t)) break;
            if (t & 1) SU_BODY(1, t); else SU_BODY(0, t);
            { bool ok = true;
              if (t + 1 < NT) { const float ub = qn * kinf[t + 1] + ((const float*)(lds + LDS_BIAS))[KBASE(t + 1) + KVBLK - 1]; ok = ub <= m_reg - DELTA_RAW; }
              const bool okw = __all(ok); if (lane == 0) votes[(t & 1) * 2 + wid] = okw ? 1u : 0u; }
        }
#undef SU_BODY
#undef SU_RESC
        if (hi == 0) li_l[r32] = l_reg; asm volatile("s_waitcnt lgkmcnt(0)" ::: "memory");
        float rli[16];
#pragma unroll
        for (int r = 0; r < 16; ++r) rli[r] = __builtin_amdgcn_rcpf(li_l[crow(r, hi)]);
        typedef __attribute__((address_space(1))) bf16_t gbf16_t;
        gbf16_t* Ow = (gbf16_t*)(cur.O + (size_t)(wid * QBLK + 4 * hi) * g.ldo + r32); const gbf16_t* Gw = (const gbf16_t*)(cur.G + (size_t)(wid * QBLK + 4 * hi) * cur.ldg + r32);
        asm volatile("" : "+v"(Ow), "+v"(Gw));
        unsigned short gq[16][4];
#pragma unroll
        for (int r = 0; r < 16; ++r) { const int orow = (r & 3) + 8 * (r >> 2);
#pragma unroll
            for (int d0 = 0; d0 < 4; ++d0) gq[r][d0] = Gw[(size_t)orow * cur.ldg + d0 * 32]; }
        SBAR();
#pragma unroll
        for (int r = 0; r < 16; ++r) { const int orow = (r & 3) + 8 * (r >> 2);
#pragma unroll
            for (int d0 = 0; d0 < 4; ++d0) { const float v = o[d0][r] * rli[r] * __uint_as_float((unsigned)gq[r][d0] << 16); Ow[(size_t)orow * g.ldo + (size_t)(d0 >> 1) * g.sdo + (d0 & 1) * 32] = (bf16_t)(cvtpk(v, v) & 0xffffu); } }
    }
#undef SU_EXIT
#undef KBASE
    __syncthreads();
}
#undef ROW
#undef KSEL
#undef VSEL
#undef VMW
#undef VMWN
#undef SLOAD_H
#undef SWRITE_HK
#undef SWRITE_HV
#undef SWRITE_H
#undef SLOAD_F
#undef SLOAD_G
#undef SWRITE_KF
#undef SWRITE_VF
#undef QROWP
#undef KSWZ
#undef SBAR
}
#define GAS __attribute__((address_space(1)))
#define LAS __attribute__((address_space(3)))
typedef unsigned short bf16;
typedef unsigned v4u __attribute__((ext_vector_type(4)));
typedef float f32x4 __attribute__((ext_vector_type(4)));
typedef short bf16x8 __attribute__((ext_vector_type(8)));
typedef GAS unsigned gu32;
typedef GAS unsigned long long gu64;
#define RLX_AGENT __ATOMIC_RELAXED, __HIP_MEMORY_SCOPE_AGENT
#define LDS_WAIT() asm volatile("s_waitcnt lgkmcnt(0)" ::: "memory")
#define VM_WAIT() asm volatile("s_waitcnt vmcnt(0)" ::: "memory")
__device__ __forceinline__ unsigned long long rt() { return __builtin_amdgcn_s_memrealtime(); }
__device__ __forceinline__ unsigned f2bf(float f) { unsigned u = __builtin_bit_cast(unsigned, f); return (u + 0x7fffu + ((u >> 16) & 1u)) >> 16; }
__device__ __forceinline__ unsigned pk2(float lo, float hi) { return f2bf(lo) | (f2bf(hi) << 16); }

#define XB_TMO      128
#define XB_XCNT(j)  (256  + 64 * (j))
#define XB_XSUB(j)  (1280 + 64 * (j))
#define XB_XGEN(j)  (2304 + 64 * (j))
#define XB_TOP      3328
#define XB_TOPGEN   3392
#define XCD_BAR_WORDS 3456
#define XB_SPIN_CAP (1u << 18)

__device__ __forceinline__ unsigned xb_ld(unsigned* p)              { return __hip_atomic_load(p, __ATOMIC_RELAXED, __HIP_MEMORY_SCOPE_AGENT); }
__device__ __forceinline__ unsigned xb_add(unsigned* p, unsigned v) { return __hip_atomic_fetch_add(p, v, __ATOMIC_RELAXED, __HIP_MEMORY_SCOPE_AGENT); }
__device__ __forceinline__ unsigned xb_xcc_id() { return (unsigned)__builtin_amdgcn_s_getreg((3 << 11) | 20) & 0xFu; }
#define XB_SPIN(cond, bar) do { unsigned _sp = 0; while (cond) { __builtin_amdgcn_s_sleep(1); \
    if ((++_sp & 255u) == 0u) { if (xb_ld(&(bar)[XB_TMO])) break; if (_sp > XB_SPIN_CAP) { atomicAdd(&(bar)[XB_TMO], 1u); break; } } } } while (0)

struct XcdBarrier {
    unsigned* bar; unsigned x;
    volatile LAS unsigned* st;
};

__device__ __forceinline__ XcdBarrier xcd_barrier_post(unsigned* bar, volatile LAS unsigned* st) {
    XcdBarrier b; b.bar = bar; b.x = xb_xcc_id(); b.st = st;
    if (threadIdx.x == 0) (void)xb_add(&bar[XB_XCNT(b.x)], 1u);
    return b;
}
__device__ __forceinline__ void xcd_barrier_complete(unsigned* bar, unsigned x, unsigned& nloc, unsigned& nx) {
    const unsigned G = gridDim.x * gridDim.y * gridDim.z;
    unsigned sum, cnt, mine, sp = 0u;
    for (;;) {
        sum = 0u; cnt = 0u; mine = 0u;
#pragma unroll
        for (unsigned j = 0; j < 16; ++j) { const unsigned c = xb_ld(&bar[XB_XCNT(j)]); sum += c; cnt += (c > 0u) ? 1u : 0u; mine = (j == x) ? c : mine; }
        if (sum == G) break;
        __builtin_amdgcn_s_sleep(1);
        if ((++sp & 255u) == 0u) { if (xb_ld(&bar[XB_TMO])) break; if (sp > XB_SPIN_CAP) { atomicAdd(&bar[XB_TMO], 1u); break; } }
    }
    nloc = mine > 0u ? mine : 1u; nx = cnt > 0u ? cnt : 1u;
}

__device__ __forceinline__ void xcd_barrier(const XcdBarrier& b) {
    asm volatile("s_waitcnt vmcnt(0)" ::: "memory");
    __syncthreads();
    if (threadIdx.x == 0) {
        unsigned* bar = b.bar;
        __builtin_amdgcn_s_waitcnt(0);
        unsigned nloc = b.st[0], nx = b.st[1];
        if (nloc == 0u) { xcd_barrier_complete(bar, b.x, nloc, nx); b.st[0] = nloc; b.st[1] = nx; }
        const unsigned old = xb_add(&bar[XB_XSUB(b.x)], 1u);
        const unsigned gen = old / nloc;
        if (old + 1u == (gen + 1u) * nloc) {
            __builtin_amdgcn_fence(__ATOMIC_RELEASE, "agent");
            asm volatile("s_waitcnt vmcnt(0)" ::: "memory");
            const unsigned og = xb_add(&bar[XB_TOP], 1u);
            const unsigned tg = og / nx;
            if (og + 1u == (tg + 1u) * nx) xb_add(&bar[XB_TOPGEN], 1u);
            else XB_SPIN(xb_ld(&bar[XB_TOPGEN]) == tg, bar);
            __builtin_amdgcn_fence(__ATOMIC_ACQUIRE, "agent");
            xb_add(&bar[XB_XGEN(b.x)], 1u);
            asm volatile("s_waitcnt vmcnt(0)" ::: "memory");
        } else {
            XB_SPIN(xb_ld(&bar[XB_XGEN(b.x)]) == gen, bar);
            __builtin_amdgcn_fence(__ATOMIC_ACQUIRE, "agent");
            asm volatile("s_waitcnt vmcnt(0)" ::: "memory");
        }
    }
    __syncthreads();
}

constexpr int NWAVES = 8;
constexpr int RING_OFF = 0, RING_BYTES = 131072;
constexpr int LDSCTL_OFF = RING_BYTES, MISC_OFF = LDSCTL_OFF + 320;
constexpr int LDS_BYTES = 147456;
static_assert(MISC_OFF + 128 <= LDS_BYTES && fa::LDS_BYTES <= RING_BYTES && pg8::STAGE_BYTES <= RING_BYTES, "LDS map");
constexpr int N_PHASES = 9;
constexpr int N_LAUNCHES = MK_N_LAUNCHES;

struct Args { const float* in[20]; float* out; unsigned char* ws; int ph_lo, ph_hi; };
static_assert(sizeof(Args) == 22 * 8 + 8, "Args has no padding");

__device__ __forceinline__ float wave_sum(float v) {
#pragma unroll
    for (int o = 1; o < 64; o <<= 1) v += __shfl_xor(v, o);
    return v;
}
typedef unsigned u32x2_ __attribute__((ext_vector_type(2)));
__device__ __forceinline__ float bf_lo(unsigned u) { return __uint_as_float(u << 16); }
__device__ __forceinline__ float bf_hi(unsigned u) { return __uint_as_float(u & 0xffff0000u); }

__device__ __forceinline__ int p8_row(int l) { const int w = l & 31, fq = w >> 3, n = (w >> 2) & 1, i = w & 3; return (l & ~31) + 16 * n + 4 * fq + i; }
__device__ __forceinline__ int wa_row(int n) {
    if (n >= 4 * CD) return p8_row(n);
    const int qi = n / CD, c = n % CD, pn = c >> 6, ch = c & 63, wc = ch >> 4, fq = (ch >> 2) & 3, i = ch & 3, bj = qi >> 1, nn = qi & 1;
    return 256 * pn + 128 * bj + 32 * wc + 16 * nn + 4 * fq + i;
}
template <int MODE>
__device__ __forceinline__ void p0_transpose_item(const float* W, int ldw, const float* gain, bf16* WT, int wt_rows, int row_off, LAS float* scr, int k0, int n0, int lane) {
    const int lr = lane >> 4, lc = (lane & 15) * 4;
#pragma unroll 4
    for (int it = 0; it < 16; ++it) { const int kk = 4 * it + lr; const float gv = gain ? gain[k0 + kk] : 1.0f;
        const f32x4 v = *(const GAS f32x4*)(W + (size_t)(k0 + kk) * ldw + n0 + lc) * gv;
        *(LAS f32x4*)(scr + kk * 64 + (lc ^ (4 * ((kk >> 3) & 7)))) = v; }
    LDS_WAIT(); asm volatile("" ::: "memory");
    const int c = lane & 7;
#pragma unroll
    for (int j = 0; j < 8; ++j) { const int n = (lane >> 3) + 8 * j; const LAS float* s = scr + (8 * c) * 64 + (n ^ (4 * c));
        v4u o; o.x = pk2(s[0 * 64], s[1 * 64]); o.y = pk2(s[2 * 64], s[3 * 64]); o.z = pk2(s[4 * 64], s[5 * 64]); o.w = pk2(s[6 * 64], s[7 * 64]);
        const int dr = MODE == 1 ? wa_row(n0 + n) : row_off + p8_row(n0 + n);
        *(GAS v4u*)(WT + ktm(dr, k0 + 8 * c, wt_rows)) = o; }
    LDS_WAIT(); asm volatile("" ::: "memory");
}
__device__ __forceinline__ void rms_row_to_bf16(const float* xrow, bf16* obase, int row, int nrows, int lane) {
    const GAS f32x4* xr = (const GAS f32x4*)xrow + lane;
    f32x4 v[8]; float s = 0.f;
#pragma unroll
    for (int j = 0; j < 8; ++j) { v[j] = xr[64 * j]; s += (v[j].x * v[j].x + v[j].y * v[j].y) + (v[j].z * v[j].z + v[j].w * v[j].w); }
    const float rstd = 1.0f / sqrtf(wave_sum(s) * (1.f / DM) + EPS);
    GAS bf16* o8 = (GAS bf16*)obase + ktm(row, 4 * lane, nrows);
#pragma unroll
    for (int j = 0; j < 8; ++j) *(GAS unsigned long long*)(o8 + (size_t)(4 * j) * nrows * 64) = (unsigned long long)pk2(v[j].x * rstd, v[j].y * rstd) | ((unsigned long long)pk2(v[j].z * rstd, v[j].w * rstd) << 32);
}
__device__ __forceinline__ float log_sigmoid(float v) { return v >= 0.f ? -log1pf(expf(-v)) : v - log1pf(expf(v)); }

__global__ void __launch_bounds__(NWAVES * 64, 2) yoco_fwd(Args args) {
    extern __shared__ __attribute__((aligned(16))) unsigned char lds[];
    LAS unsigned char* const ldsl = (LAS unsigned char*)lds;
    volatile LAS unsigned* const MISC = (volatile LAS unsigned*)(ldsl + MISC_OFF);
    const int wave = __builtin_amdgcn_readfirstlane(threadIdx.x >> 6);
    const int G = gridDim.x; const int bx = blockIdx.x; const int vcu = (G % 8 == 0) ? (bx % 8) * (G / 8) + bx / 8 : bx;
    const int gw = vcu * NWAVES + wave, NGW = G * NWAVES;
    gu32* const ctl = (gu32*)(args.ws + WS_CTL);
#define LANE() ((int)__builtin_amdgcn_mbcnt_hi(~0u, __builtin_amdgcn_mbcnt_lo(~0u, 0u)))
#define PHASE_ENV() const __attribute__((address_space(4))) Args* ap = (const __attribute__((address_space(4))) Args*)__builtin_amdgcn_kernarg_segment_ptr(); asm volatile("" : "+s"(ap)); \
    unsigned char* const ws = ap->ws; float* const dout = ap->out; int tid = threadIdx.x; asm volatile("" : "+v"(tid)); const int lane = tid & 63; (void)ws; (void)dout; (void)lane
#define INP(k) (ap->in[k])
#define WSP(T, off) ((T*)(ws + (off)))

    for (int u = threadIdx.x; u < (LDS_BYTES - LDSCTL_OFF) / 4; u += NWAVES * 64) ((LAS unsigned*)(ldsl + LDSCTL_OFF))[u] = 0u;
    __syncthreads();
    XcdBarrier bar; bar.bar = (unsigned*)(ctl + CW_BAR); bar.x = 0; bar.st = nullptr;
    if (N_LAUNCHES == 1) bar = xcd_barrier_post((unsigned*)(ctl + CW_BAR), MISC + 8);
#define GRID_BAR() do { if (N_LAUNCHES == 1) xcd_barrier(bar); } while (0)
    const int lo = args.ph_lo, hi = args.ph_hi;
#ifndef PH_MASK
#define PH_MASK 0x1ff
#endif
#define IN(k) ((((PH_MASK) >> (k)) & 1) && lo <= (k) && (k) < hi)
#define BOTH(k) (IN(k) && IN((k) + 1))
#ifndef REP_MASK
#define REP_MASK 0x0
#endif
#ifndef SAMPLE_CUS_PER_XCD
#define SAMPLE_CUS_PER_XCD 12
#endif
#ifndef REP_SAMPLE
#define REP_SAMPLE 0
#endif
#ifndef REP_FOX
#define REP_FOX 0
#endif
#define REPS(k) _Pragma("unroll") for (int rep_ = 0; rep_ < ((((REP_MASK) >> (k)) & 1) ? 2 : 1); ++rep_)

    REPS(0) if (IN(0)) {
        PHASE_ENV();
        const float* x_prompt = INP(0); const float* x_sample = INP(1); const float* cache_mem_k = INP(6); const float* cache_mem_v = INP(7); const float* mem_prompt = INP(8); const float* g_norm = INP(9);
        const float* w_in_a = INP(10); const float* w_in_b = INP(12); const float* w_out = INP(13); const float* g_mem = INP(14); const float* w_mem_kv = INP(15); const float* g_kv = INP(16); const float* w_kvf = INP(17);
        bf16* const WA = WSP(bf16, WS_WA); bf16* const WB = WSP(bf16, WS_WB); bf16* const WO = WSP(bf16, WS_WO); float* const WF = WSP(float, WS_WF); bf16* const XN = WSP(bf16, WS_XN); bf16* const MEMK = WSP(bf16, WS_MEMK); bf16* const MEMV = WSP(bf16, WS_MEMV);
        LAS float* scr = (LAS float*)(ldsl + RING_OFF + wave * 16384);
        constexpr int KB_ = DM / 64;
        constexpr int I_A = KB_ * (INA / 64), I_O = KB_ * (DM / 64), I_M = KB_ * (2 * MD / 64);
        constexpr int NITEMS = I_A + I_O + 2 * I_M;
        for (int it = gw; it < NITEMS; it += NGW) {
            int r = it;
            if (r < I_A) { p0_transpose_item<1>(w_in_a, INA, g_norm, WA, WA_ROWS, 0, scr, 64 * (r / (INA / 64)), 64 * (r % (INA / 64)), lane); continue; } r -= I_A;
            if (r < I_O) { p0_transpose_item<0>(w_out, DM, nullptr, WO, DM, 0, scr, 64 * (r / (DM / 64)), 64 * (r % (DM / 64)), lane); continue; } r -= I_O;
            { const int l = r / I_M; r -= l * I_M; p0_transpose_item<0>(w_mem_kv + (size_t)l * DM * 2 * MD, 2 * MD, g_mem + l * DM, WA, WA_ROWS, INA + l * 2 * MD, scr, 64 * (r / (2 * MD / 64)), 64 * (r % (2 * MD / 64)), lane); }
        }
#define P0_ROW(m_) ((const GAS f32x4*)((m_) < MP ? x_prompt + (size_t)(m_) * DM : ((m_) < MT ? x_sample + (size_t)((m_) - MP) * DM : mem_prompt + (size_t)((m_) - MT) * DM)) + lane)
        { f32x4 xa[8];
          { const GAS f32x4* xr = P0_ROW(gw < XN_ROWS ? gw : 0);
#pragma unroll
            for (int j = 0; j < 8; ++j) xa[j] = xr[64 * j]; }
          for (int m = gw; m < XN_ROWS; m += NGW) {
              f32x4 xb[8];
              { const GAS f32x4* xr = P0_ROW(m + NGW < XN_ROWS ? m + NGW : m);
#pragma unroll
                for (int j = 0; j < 8; ++j) xb[j] = xr[64 * j]; }
              float s = 0.f;
#pragma unroll
              for (int j = 0; j < 8; ++j) s += (xa[j].x * xa[j].x + xa[j].y * xa[j].y) + (xa[j].z * xa[j].z + xa[j].w * xa[j].w);
              const float rstd = 1.0f / sqrtf(wave_sum(s) * (1.f / DM) + EPS);
              if (lane == 0 && m < MT) WSP(float, WS_RS0)[m] = rstd;
              GAS bf16* o8 = (GAS bf16*)XN + ktm(m, 4 * lane, XN_ROWS);
#pragma unroll
              for (int j = 0; j < 8; ++j) *(GAS unsigned long long*)(o8 + (size_t)(4 * j) * XN_ROWS * 64) = (unsigned long long)pk2(xa[j].x * rstd, xa[j].y * rstd) | ((unsigned long long)pk2(xa[j].z * rstd, xa[j].w * rstd) << 32);
#pragma unroll
              for (int j = 0; j < 8; ++j) xa[j] = xb[j];
          } }
#undef P0_ROW
        { constexpr int PER = NMEM * MD / 8;
          for (int i = gw * 64 + lane; i < 2 * SB * PER; i += NGW * 64) {
              const int kv = i / (SB * PER), r = i % (SB * PER), b = r / PER, e = r % PER;
              const float* src = (kv ? cache_mem_v : cache_mem_k) + ((size_t)b * PER + e) * 8; bf16* dst = (kv ? MEMV : MEMK) + ((size_t)(PB + b) * PER + e) * 8;
              const f32x4 a = *(const f32x4*)src, c = *(const f32x4*)(src + 4); v4u o; o.x = pk2(a.x, a.y); o.y = pk2(a.z, a.w); o.z = pk2(c.x, c.y); o.w = pk2(c.z, c.w); *(v4u*)dst = o; } }
        for (int i = gw * 64 + lane; i < 16 * DM; i += NGW * 64) { const int j = i / DM, k = i % DM; const float v = j < NHF ? g_kv[k] * w_kvf[(size_t)k * KVF + 2 * CD + j] : 0.f;
            ((unsigned short*)WF)[((k >> 5) * 16 + j) * 32 + (k & 31)] = (unsigned short)(pk2(v, 0.f) & 0xffffu); }
        if (BOTH(0)) GRID_BAR();
    }

    REPS(1) if (IN(1)) {
        PHASE_ENV();
        bf16* const XN = WSP(bf16, WS_XN); bf16* const WA = WSP(bf16, WS_WA);
        pg8::Gemm g{XN, WA, XN_ROWS, WA_ROWS, DM}; pg8::GridOrder S; S.init(MP / 256, INA / 256, G, bx, 8 * 28, MP, 0, 28, 4 * 8, MT, 28, 8);
        pg8::EpiA E{WSP(bf16, WS_MIX), WSP(bf16, WS_QM), WSP(bf16, WS_SZM), WSP(bf16, WS_MEMK), WSP(bf16, WS_MEMV), dout, WSP(float, WS_FCU), WSP(float, WS_FBZ), WSP(float, WS_LCU), INP(11)};
        pg8::gemm_phase<pg8::EpiA, pg8::GridOrder, true, true>(ldsl + RING_OFF, g, S, E);
        if (BOTH(1)) GRID_BAR();
    }

    REPS(2) if (IN(2)) {
        PHASE_ENV();
        const float* state_conv = INP(2); const float* conv_w = INP(11);
        bf16* const QMb = WSP(bf16, WS_QM); bf16* const SZMb = WSP(bf16, WS_SZM); bf16* const MIX = WSP(bf16, WS_MIX); bf16* const MEMK = WSP(bf16, WS_MEMK); bf16* const MEMV = WSP(bf16, WS_MEMV);
        { const float* const FCU = WSP(float, WS_FCU); const float* const FBZ = WSP(float, WS_FBZ); const float* const LCU = WSP(float, WS_LCU);
          for (int it = gw; it < (MT / 64) * 3; it += NGW) {
            const int g64 = it / 3, cc = it % 3, r0 = g64 * 64, c0 = cc * 512 + lane * 8;
            float w0[8], w1[8], w2[8], h2[8], h1[8], cu0[8], cu1[8], bz0[8], bz1[8];
#pragma unroll
            for (int j = 0; j < 8; ++j) { w0[j] = conv_w[c0 + j]; w1[j] = conv_w[CD + c0 + j]; w2[j] = conv_w[2 * CD + c0 + j]; }
            const bool pr = r0 < MP;
            if (pr && (r0 & (PT - 1)) == 0) {
#pragma unroll
                for (int j = 0; j < 8; ++j) { h2[j] = 0.f; h1[j] = 0.f; } }
            else { const float* sp = pr ? LCU + (size_t)(g64 - 1) * 2 * CD + c0 : state_conv + (size_t)((r0 - MP) / ST) * 2 * CD + c0;
#pragma unroll
                for (int j = 0; j < 8; ++j) { h2[j] = sp[j]; h1[j] = sp[CD + j]; } }
            { const float* fc = FCU + (size_t)g64 * 2 * CD + c0; const float* fb = FBZ + (size_t)g64 * 2 * CD + c0;
#pragma unroll
              for (int j = 0; j < 8; ++j) { cu0[j] = fc[j]; cu1[j] = fc[CD + j]; bz0[j] = fb[j]; bz1[j] = fb[CD + j]; } }
            float o0[8], o1[8];
#pragma unroll
            for (int j = 0; j < 8; ++j) { o0[j] = bz0[j] * (w0[j] * h2[j] + w1[j] * h1[j] + w2[j] * cu0[j]); o1[j] = bz1[j] * (w0[j] * h1[j] + w1[j] * cu0[j] + w2[j] * cu1[j]); }
            v4u w; w.x = pk2(o0[0], o0[1]); w.y = pk2(o0[2], o0[3]); w.z = pk2(o0[4], o0[5]); w.w = pk2(o0[6], o0[7]); *(v4u*)(MIX + ktm(r0, c0, MT)) = w;
            w.x = pk2(o1[0], o1[1]); w.y = pk2(o1[2], o1[3]); w.z = pk2(o1[4], o1[5]); w.w = pk2(o1[6], o1[7]); *(v4u*)(MIX + ktm(r0 + 1, c0, MT)) = w;
          } }
        {
            __syncthreads();
            const fa::Geom gm{64, 0x7fffffff, (size_t)MT * 64};
            auto mk = [=](int idx) { const int blk = idx >> 2, h = idx & 3; const bool pr = blk < 64; const int row0 = pr ? blk * 256 : MP + (blk - 64) * ST, mb = pr ? (blk >> 5) : PB + (blk - 64);
                fa::BlockRef<fa::bf16_t> r; r.Q = QMb + (size_t)row0 * MD + h * HD; r.K = MEMK + (size_t)(0 * NMB + mb) * NMEM * MD + h * HD; r.V = MEMV + (size_t)(0 * NMB + mb) * NMEM * MD + h * HD; r.K2 = r.K; r.V2 = r.V;
                r.O = MIX + ktm(row0, CD + h * HD, MT); r.G = SZMb + (size_t)row0 * MD + h * HD; r.bias = nullptr; r.kmax = nullptr; r.P0 = 1 << 20; r.skv = NMEM; r.nvalid = pr ? 256 : ST; r.ldq = MD; r.ldk = MD; r.ldg = MD; return r; };
            if (vcu < 320) {
                fa::Seam<fa::bf16_t> Sm; fa::BlockRef<fa::bf16_t> cur = mk(vcu); fa::attn_prime<fa::bf16_t>(cur, gm, (char*)lds + RING_OFF, Sm);
                for (int idx = vcu; idx < 320; idx += G) { const bool more = idx + G < 320; const fa::BlockRef<fa::bf16_t> nxt = more ? mk(idx + G) : cur;
                    fa::attn_block<fa::bf16_t, false, fa::NoQueue>(cur, nxt, gm, (char*)lds + RING_OFF, Sm, fa::NoQueue{}); cur = nxt; }
            }
        }
        if (BOTH(2)) GRID_BAR();
    }

    REPS(3) if (IN(3)) {
        PHASE_ENV();
        bf16* const MIX = WSP(bf16, WS_MIX); bf16* const WO = WSP(bf16, WS_WO);
        pg8::Gemm g{MIX, WO, MT, DM, DM}; pg8::GridOrder S; S.init(MP / 256, DM / 256, G, bx, 8 * 8, MP, 0, 8);
        pg8::EpiX1 E{WSP(bf16, WS_XN), XN_ROWS, WSP(float, WS_RS0), WSP(bf16, WS_XU), WSP(float, WS_CTL) + CW_SS1};
        pg8::gemm_phase<pg8::EpiX1, pg8::GridOrder, true, true>(ldsl + RING_OFF, g, S, E);
        const int cv0 = G > 64 ? 64 : 0;
        if (bx >= cv0) {
            const float* w_in_b = INP(12); const float* w_out = INP(13); const float* g_norm = INP(9); const float* g_kv = INP(16); const float* w_kvf = INP(17); const float* cache_mem_k = INP(6); const float* cache_mem_v = INP(7);
            bf16* const WB = WSP(bf16, WS_WB); bf16* const MEMK = WSP(bf16, WS_MEMK); bf16* const MEMV = WSP(bf16, WS_MEMV);
            LAS float* scr = (LAS float*)(ldsl + RING_OFF + wave * 16384);
            const int w2 = (bx - cv0) * NWAVES + wave, NW2 = (G - cv0) * NWAVES;
            constexpr int KB_ = DM / 64; constexpr int I_KV = KB_ * (2 * CD / 64), I_B = KB_ * (INB / 64), I_O = KB_ * (DM / 64);
            for (int it = w2; it < I_KV + I_B + I_O; it += NW2) {
                int r = it;
                if (r < I_KV) { p0_transpose_item<0>(w_kvf, KVF, g_kv, WB, INA, 0, scr, 64 * (r / (2 * CD / 64)), 64 * (r % (2 * CD / 64)), lane); continue; } r -= I_KV;
                if (r < I_B) { p0_transpose_item<0>(w_in_b, INB, g_norm + DM, WB, INA, 2 * CD, scr, 64 * (r / (INB / 64)), 64 * (r % (INB / 64)), lane); continue; } r -= I_B;
                p0_transpose_item<0>(w_out + (size_t)DM * DM, DM, nullptr, WO + (size_t)DM * DM, DM, 0, scr, 64 * (r / (DM / 64)), 64 * (r % (DM / 64)), lane);
            }
            constexpr int PER = NMEM * MD / 8;
            for (int i = w2 * 64 + lane; i < 2 * SB * PER; i += NW2 * 64) {
                const int kv = i / (SB * PER), r = i % (SB * PER), b = r / PER, e = r % PER;
                const float* src = (kv ? cache_mem_v : cache_mem_k) + ((size_t)(SB + b) * PER + e) * 8; bf16* dst = (kv ? MEMV : MEMK) + ((size_t)(NMB + PB + b) * PER + e) * 8;
                const f32x4 a = *(const f32x4*)src, c = *(const f32x4*)(src + 4); v4u o; o.x = pk2(a.x, a.y); o.y = pk2(a.z, a.w); o.z = pk2(c.x, c.y); o.w = pk2(c.z, c.w); *(v4u*)dst = o; }
        }
        if (BOTH(3)) GRID_BAR();
    }

    REPS(4) if (IN(4)) {
        PHASE_ENV();
        const float* b_f = INP(18); const float* const WF = WSP(float, WS_WF); const bf16* const XU = WSP(bf16, WS_XU); const float* const SS1 = WSP(float, WS_CTL) + CW_SS1;
        const int fr = lane & 15, fq = lane >> 4;
        const int gi = wave * G + bx;
        const bool has = gi < MT / 16; const int row = (has ? gi : 0) * 16 + fr;
        const GAS bf16* xp = (const GAS bf16*)XU + ktm(row, fq * 8, MT);
#define P4_X(ks) (*(const GAS pg8::bf16x8*)(xp + (size_t)((ks) >> 1) * MT * 64 + ((ks) & 1) * 32))
        pg8::bf16x8 xa[16], xb[16];
#pragma unroll
        for (int k = 0; k < 16; ++k) xa[k] = P4_X(k);
#pragma unroll
        for (int k = 0; k < 16; ++k) xb[k] = P4_X(16 + k);
        const float ssr = SS1[row]; f32x4 bfv = {0.f, 0.f, 0.f, 0.f}; if (fq < 3) bfv = *(const f32x4*)(b_f + fq * 4);
        LAS unsigned* wl = (LAS unsigned*)(ldsl + RING_OFF);
        { v4u wv[8];
#pragma unroll
          for (int j = 0; j < 8; ++j) wv[j] = ((const v4u*)WF)[tid + NWAVES * 64 * j];
#pragma unroll
          for (int j = 0; j < 8; ++j) ((LAS v4u*)wl)[tid + NWAVES * 64 * j] = wv[j]; }
        __syncthreads();
        const LAS unsigned char* wb = (const LAS unsigned char*)wl + fr * 64 + fq * 16;
        f32x4 acc = {0.f, 0.f, 0.f, 0.f};
#define P4_MM(xs, k0) _Pragma("unroll") for (int k = 0; k < 16; ++k) acc = __builtin_amdgcn_mfma_f32_16x16x32_bf16(*(const LAS pg8::bf16x8*)(wb + ((k0) + k) * 1024), xs[k], acc, 0, 0, 0)
        P4_MM(xa, 0);
#pragma unroll
        for (int k = 0; k < 16; ++k) xa[k] = P4_X(32 + k);
        P4_MM(xb, 16);
#pragma unroll
        for (int k = 0; k < 16; ++k) xb[k] = P4_X(48 + k);
        P4_MM(xa, 32);
        P4_MM(xb, 48);
#undef P4_MM
#undef P4_X
        if (has && fq < 3) {
            const float rstd = 1.0f / sqrtf(ssr * (1.f / DM) + EPS);
            f32x4 lf;
#pragma unroll
            for (int r = 0; r < 4; ++r) lf[r] = log_sigmoid(acc[r] * rstd + bfv[r]);
            float* dst = row < MP ? dout + OO_PLOGF + (size_t)row * NHF : dout + OO_SLOGF + (size_t)(row - MP) * NHF;
            *(f32x4*)(dst + fq * 4) = lf;
        }
        __syncthreads();
        if (BOTH(4)) GRID_BAR();
    }

    REPS(5) if (IN(5)) {
        PHASE_ENV();
        const bool ovl = N_LAUNCHES == 1 && BOTH(5) && (REP_MASK & 0xe0) == 0;
        const float* cache_logf = INP(5); bf16* const XU = WSP(bf16, WS_XU); bf16* const WB = WSP(bf16, WS_WB); float* const KBIAS = WSP(float, WS_KBIAS);
        gu32* const ctlw = (gu32*)(ws + WS_CTL);
        for (int pair = bx; pair < NMB * NHF; pair += G) {
            LAS float* tot = (LAS float*)(ldsl + RING_OFF);
            const int sq = pair / NHF, hh = pair % NHF; const bool pr = sq < PB; const int len = pr ? PT : SKV_S; const int t0 = tid * 16; const bool actv = t0 < len;
            float v[16]; float sum = 0.f;
            if (actv) { const float* src; if (pr) src = dout + OO_PLOGF + ((size_t)sq * PT + t0) * NHF + hh; else { const int b = sq - PB; src = (t0 < PAST ? cache_logf + ((size_t)b * PAST + t0) * NHF : dout + OO_SLOGF + ((size_t)b * ST + (t0 - PAST)) * NHF) + hh; }
#pragma unroll
                for (int r = 0; r < 16; ++r) { sum += src[r * NHF]; v[r] = sum; } }
            else {
#pragma unroll
                for (int r = 0; r < 16; ++r) v[r] = 0.f; }
            float inc = sum;
#pragma unroll
            for (int o = 1; o < 64; o <<= 1) { const float n = __shfl_up(inc, o); if (lane >= o) inc += n; }
            if (lane == 63) tot[wave] = inc;
            __syncthreads();
            float base = inc - sum; for (int w = 0; w < wave; ++w) base += tot[w];
            if (actv) { f32x4* dst = (f32x4*)(KBIAS + (pr ? (size_t)sq * NHF * PT : KBIAS_S_OFF + (size_t)(sq - PB) * NHF * SKV_S) + (size_t)hh * len + t0); const float ns = -1.0f / fa::SCALE;
#pragma unroll
                for (int q4 = 0; q4 < 4; ++q4) dst[q4] = (f32x4){(v[4 * q4] + base) * ns, (v[4 * q4 + 1] + base) * ns, (v[4 * q4 + 2] + base) * ns, (v[4 * q4 + 3] + base) * ns}; }
            __syncthreads();
        }
        pg8::EpiB E{ws, dout, (float*)(ws + WS_CTL) + CW_KN2, (const float*)(ws + WS_CTL) + CW_SS1};
        { pg8::Gemm g{XU, WB, MT, INA, DM}; pg8::GridOrder S; S.init(0, INA / 256, G, bx, 8 * 28, MP, 0, 28);
          pg8::gemm_phase<pg8::EpiB, pg8::GridOrder, true, true>(ldsl + RING_OFF, g, S, E); }
        if (ovl) { if (bx < 8 * 28) { asm volatile("s_waitcnt vmcnt(0)" ::: "memory"); __syncthreads();
            if (tid == 0) { __builtin_amdgcn_fence(__ATOMIC_RELEASE, "agent"); asm volatile("s_waitcnt vmcnt(0)" ::: "memory"); __hip_atomic_fetch_add(ctlw + CW_C2, 1u, RLX_AGENT); } } }
        { pg8::Gemm g{XU, WB, MT, INA, DM}; pg8::GridOrder S; S.init(MP / 256, INA / 256, G, bx);
          pg8::gemm_phase<pg8::EpiB, pg8::GridOrder, true, true>(ldsl + RING_OFF, g, S, E); }
        if (ovl) { asm volatile("s_waitcnt vmcnt(0)" ::: "memory"); __syncthreads();
            if (tid == 0) { __builtin_amdgcn_fence(__ATOMIC_RELEASE, "agent"); asm volatile("s_waitcnt vmcnt(0)" ::: "memory"); __hip_atomic_fetch_add(ctlw + CW_C1, 1u, RLX_AGENT); } }
        if (!ovl && BOTH(5)) GRID_BAR();
    }

    REPS(6) if (IN(6)) {
        PHASE_ENV();
        const float* cache_k = INP(3); const float* cache_v = INP(4);
        bf16* const QMb = WSP(bf16, WS_QM); bf16* const SZMb = WSP(bf16, WS_SZM); bf16* const MIX = WSP(bf16, WS_MIX); bf16* const KBb = WSP(bf16, WS_KB); bf16* const VBb = WSP(bf16, WS_VB);
        bf16* const QFb = WSP(bf16, WS_QF); bf16* const SZFb = WSP(bf16, WS_SZF); bf16* const MEMK = WSP(bf16, WS_MEMK); bf16* const MEMV = WSP(bf16, WS_MEMV); float* const KBIAS = WSP(float, WS_KBIAS);
        char* const al = (char*)lds + RING_OFF; gu32* const ctlw = (gu32*)(ws + WS_CTL);
        const bool ovl6 = N_LAUNCHES == 1 && IN(5) && (REP_MASK & 0xe0) == 0;
        const unsigned nC2 = (unsigned)(G < 8 * 28 ? G : 8 * 28);
#define WAIT_CTR(word_, want_) do { if (wave == 0) { unsigned sp_ = 0; while ((unsigned)__builtin_amdgcn_readfirstlane(__hip_atomic_load(ctlw + (word_), RLX_AGENT)) < (want_)) { __builtin_amdgcn_s_sleep(8); if (++sp_ > (1u << 22)) break; } \
            __builtin_amdgcn_fence(__ATOMIC_ACQUIRE, "agent"); asm volatile("s_waitcnt vmcnt(0)" ::: "memory"); } __syncthreads(); } while (0)
        const bool p7in6 = N_LAUNCHES == 1 && BOTH(6) && (REP_MASK & 0xe0) == 0 && ((G + 31) >> 5) * SAMPLE_CUS_PER_XCD >= 8 * 8;
        bool c2w = !ovl6;
        if (ovl6) WAIT_CTR(CW_C1, (unsigned)G);
        {
            const fa::Geom gs{64, PAST, (size_t)MT * 64};
            const int i = vcu & 31;
            const int nS = ((G + 31) >> 5) * SAMPLE_CUS_PER_XCD, sidx = (vcu >> 5) * SAMPLE_CUS_PER_XCD + i;
            const int UPC = (i < SAMPLE_CUS_PER_XCD && sidx < SB * NHF) ? (SB * NHF - sidx + nS - 1) / nS : 0;
            if (UPC > 0) {
                if (!c2w) { WAIT_CTR(CW_C2, nC2); c2w = true; }
                auto mks = [=](int k) { const int su = sidx + k * nS; const int b = su / NHF, h = su % NHF; const size_t row0 = (size_t)MP + (size_t)b * ST;
                    fa::BlockRef<float> r; r.Q = QFb + row0 * CD + h * HD; r.K = cache_k + (size_t)b * PAST * CD + h * HD; r.V = cache_v + (size_t)b * PAST * CD + h * HD;
                    r.K2 = dout + OO_SK + (size_t)b * ST * CD + h * HD - (size_t)PAST * CD; r.V2 = dout + OO_SV + (size_t)b * ST * CD + h * HD - (size_t)PAST * CD;
                    r.O = MIX + ktm((int)row0, h * HD, MT); r.G = SZFb + row0 * CD + h * HD; r.bias = KBIAS + KBIAS_S_OFF + (size_t)su * SKV_S; r.kmax = nullptr; r.P0 = PAST; r.skv = SKV_S; r.nvalid = ST; r.ldq = CD; r.ldk = CD; r.ldg = CD; return r; };
                for (int rs_ = 0; rs_ < 1 + REP_SAMPLE; ++rs_)
                for (int k = 0; k < UPC; ++k) fa::sample_unit(mks(k), gs, al);
            }
            if (p7in6 && i < SAMPLE_CUS_PER_XCD && sidx < nS) {
                if (!c2w) { WAIT_CTR(CW_C2, nC2); c2w = true; }
                const fa::Geom gm2{64, 0x7fffffff, (size_t)MT * 64};
                for (int it = sidx; it < SB * NHM; it += nS) {
                    const int blk = 64 + (it >> 2), h = it & 3; const int row0 = MP + (blk - 64) * ST, mb = PB + (blk - 64);
                    fa::BlockRef<fa::bf16_t> r; r.Q = QMb + (size_t)row0 * MD + h * HD; r.K = MEMK + (size_t)(1 * NMB + mb) * NMEM * MD + h * HD; r.V = MEMV + (size_t)(1 * NMB + mb) * NMEM * MD + h * HD; r.K2 = r.K; r.V2 = r.V;
                    r.O = MIX + ktm(row0, CD + h * HD, MT); r.G = SZMb + (size_t)row0 * MD + h * HD; r.bias = nullptr; r.kmax = nullptr; r.P0 = 1 << 20; r.skv = NMEM; r.nvalid = ST; r.ldq = MD; r.ldk = MD; r.ldg = MD;
                    __syncthreads(); fa::Seam<fa::bf16_t> Sm2; fa::attn_prime<fa::bf16_t>(r, gm2, al, Sm2); fa::attn_block<fa::bf16_t, false, fa::NoQueue>(r, r, gm2, al, Sm2, fa::NoQueue{});
                }
                asm volatile("s_waitcnt vmcnt(0)" ::: "memory"); __syncthreads();
                if (tid == 0) { __builtin_amdgcn_fence(__ATOMIC_RELEASE, "agent"); asm volatile("s_waitcnt vmcnt(0)" ::: "memory"); __hip_atomic_fetch_add(ctlw + CW_C3, 1u, RLX_AGENT); }
                if (sidx < 8 * 8) {
                    WAIT_CTR(CW_C3, (unsigned)nS);
                    bf16* const WO = WSP(bf16, WS_WO); bf16* const D2 = WSP(bf16, WS_D2);
                    pg8::Gemm g{MIX, WO + (size_t)DM * DM, MT, DM, DM}; pg8::GridOrder S; S.init(0, DM / 256, 1 << 20, sidx, 8 * 8, MP, 0, 8); S.noFull = 1;
                    pg8::EpiD E{D2};
                    pg8::gemm_phase<pg8::EpiD, pg8::GridOrder, true, true>(ldsl + RING_OFF, g, S, E);
                }
            }
        }
        {
            const fa::Geom gd{64, 0x7fffffff, (size_t)MT * 64};
            const float* const kn2f = (const float*)(ws + WS_CTL) + CW_KN2;
            const int xg = vcu >> 5;
            auto mk = [=](int stage, int n) {
                fa::BlockRef<fa::bf16_t> r;
                if (stage < 8) { if (REP_FOX) n %= 96; const int xq = (xg + stage) & 7, bh = 3 * xq + n % 3, qb = 31 - n / 3, b = bh / NHF, h = bh % NHF; const size_t row0 = (size_t)b * PT + (size_t)qb * 256;
                    r.Q = QFb + row0 * CD + h * HD; r.K = KBb + (size_t)b * PT * CD + h * HD; r.V = VBb + (size_t)b * PT * CD + h * HD; r.O = MIX + ktm((int)row0, h * HD, MT); r.G = SZFb + row0 * CD + h * HD;
                    r.bias = KBIAS + (size_t)bh * PT; r.kmax = kn2f + (size_t)bh * PT; r.P0 = qb * 256; r.skv = PT; r.nvalid = 256; r.ldq = CD; r.ldk = CD; r.ldg = CD; }
                else { const int blk = n >> 2, h = n & 3; const bool pr = blk < 64; const int row0 = pr ? blk * 256 : MP + (blk - 64) * ST, mb = pr ? (blk >> 5) : PB + (blk - 64);
                    r.Q = QMb + (size_t)row0 * MD + h * HD; r.K = MEMK + (size_t)(1 * NMB + mb) * NMEM * MD + h * HD; r.V = MEMV + (size_t)(1 * NMB + mb) * NMEM * MD + h * HD; r.O = MIX + ktm(row0, CD + h * HD, MT); r.G = SZMb + (size_t)row0 * MD + h * HD;
                    r.bias = nullptr; r.kmax = nullptr; r.P0 = 1 << 20; r.skv = NMEM; r.nvalid = pr ? 256 : ST; r.ldq = MD; r.ldk = MD; r.ldg = MD; }
                r.K2 = r.K; r.V2 = r.V; return r; };
            int stage = 0;
#define Q_CTR(st) ((unsigned*)(ctlw + rep_ * 1024 + ((st) < 8 ? CW_QFOX + 64 * ((xg + (st)) & 7) : CW_QMEM)))
#define Q_LIM(st) ((st) < 8 ? 96 * (1 + REP_FOX) : (p7in6 ? 256 : 320))
#define Q_DRAW(n_out) do { if (tid == 0) { int st_ = stage, v_ = 0; while (st_ < 9) { v_ = (int)__hip_atomic_fetch_add(Q_CTR(st_), 1u, RLX_AGENT); if (v_ < Q_LIM(st_)) break; ++st_; }                  \
                               *(volatile int*)(al + fa::LDS_QSLOT) = v_; *(volatile int*)(al + fa::LDS_QSLOT + 4) = st_; }                                                                       \
                           __syncthreads(); n_out = __builtin_amdgcn_readfirstlane(*(volatile int*)(al + fa::LDS_QSLOT)); stage = __builtin_amdgcn_readfirstlane(*(volatile int*)(al + fa::LDS_QSLOT + 4)); __syncthreads(); } while (0)
            int n_cur, n_nxt, st_cur, st_nxt;
            Q_DRAW(n_cur); st_cur = stage;
            if (st_cur < 9) {
                Q_DRAW(n_nxt); st_nxt = stage;
                if (!c2w && (st_cur == 8 || st_nxt == 8)) { WAIT_CTR(CW_C2, nC2); c2w = true; }
                fa::Seam<fa::bf16_t> Sm; fa::BlockRef<fa::bf16_t> cur = mk(st_cur, n_cur); fa::attn_prime<fa::bf16_t>(cur, gd, al, Sm);
                for (;;) {
                    const bool has_nxt = st_nxt < 9;
                    const fa::BlockRef<fa::bf16_t> nxt = has_nxt ? mk(st_nxt, n_nxt) : cur;
                    const int st_issue = stage < 9 ? stage : 8;
                    fa::attn_block<fa::bf16_t, true, fa::AtomQueue>(cur, nxt, gd, al, Sm, fa::AtomQueue{Q_CTR(st_issue)});
                    if (!has_nxt) break;
                    int n_nn = __builtin_amdgcn_readfirstlane(*(volatile int*)(al + fa::LDS_QSLOT)); int st_nn = st_issue;
                    if (stage >= 9) st_nn = 9;
                    else if (n_nn >= Q_LIM(st_issue)) { stage = st_issue + 1; __syncthreads(); Q_DRAW(n_nn); st_nn = stage; }
                    if (!c2w && st_nn == 8) { WAIT_CTR(CW_C2, nC2); c2w = true; }
                    cur = nxt; n_nxt = n_nn; st_nxt = st_nn;
                }
            }
#undef Q_DRAW
#undef Q_LIM
#undef Q_CTR
        }
#undef WAIT_CTR
        if (BOTH(6)) GRID_BAR();
    }

    REPS(7) if (IN(7)) {
        PHASE_ENV();
        bf16* const MIX = WSP(bf16, WS_MIX); bf16* const WO = WSP(bf16, WS_WO); bf16* const D2 = WSP(bf16, WS_D2);
        const bool p7in6_ = N_LAUNCHES == 1 && IN(6) && (REP_MASK & 0xe0) == 0 && ((G + 31) >> 5) * SAMPLE_CUS_PER_XCD >= 8 * 8;
        pg8::Gemm g{MIX, WO + (size_t)DM * DM, MT, DM, DM}; pg8::GridOrder S; S.init(MP / 256, DM / 256, G, bx, p7in6_ ? 0 : 8 * 8, MP, 0, 8);
        pg8::EpiD E{D2};
        pg8::gemm_phase<pg8::EpiD, pg8::GridOrder, true, true>(ldsl + RING_OFF, g, S, E);
        if (BOTH(7)) GRID_BAR();
    }

    REPS(8) if (IN(8)) {
        PHASE_ENV();
        const float* g_final = INP(19); const bf16* const XU = WSP(bf16, WS_XU); const bf16* const D2 = WSP(bf16, WS_D2);
        f32x4 gf[8];
#pragma unroll
        for (int j = 0; j < 8; ++j) gf[j] = ((const f32x4*)g_final)[64 * j + lane];
#define P8_LOAD(m_, xq, dq) do { const GAS bf16* xn_ = (const GAS bf16*)XU + ktm((m_), 4 * lane, MT); const GAS u32x2_* d2_ = (const GAS u32x2_*)(D2 + (size_t)(m_) * DM) + lane;   \
            _Pragma("unroll") for (int j = 0; j < 8; ++j) { xq[j] = *(const GAS u32x2_*)(xn_ + (size_t)(4 * j) * MT * 64); dq[j] = d2_[64 * j]; } } while (0)
        u32x2_ xa[8], da[8];
        { const int m0 = gw < MT ? gw : 0; P8_LOAD(m0, xa, da); }
        for (int m = gw; m < MT; m += NGW) {
            u32x2_ xb[8], db[8];
            { const int m2 = m + NGW < MT ? m + NGW : m; P8_LOAD(m2, xb, db); }
            GAS f32x4* xr = (GAS f32x4*)(dout + OO_Y + (size_t)m * DM) + lane;
            f32x4 v[8]; float s = 0.f;
#pragma unroll
            for (int j = 0; j < 8; ++j) { const u32x2_ a = xa[j], b = da[j]; v[j] = (f32x4){bf_lo(a.x), bf_hi(a.x), bf_lo(a.y), bf_hi(a.y)} + (f32x4){bf_lo(b.x), bf_hi(b.x), bf_lo(b.y), bf_hi(b.y)}; s += (v[j].x * v[j].x + v[j].y * v[j].y) + (v[j].z * v[j].z + v[j].w * v[j].w); }
            const float rstd = 1.0f / sqrtf(wave_sum(s) * (1.f / DM) + EPS);
#pragma unroll
            for (int j = 0; j < 8; ++j) xr[64 * j] = v[j] * rstd * gf[j];
#pragma unroll
            for (int j = 0; j < 8; ++j) { xa[j] = xb[j]; da[j] = db[j]; }
        }
#undef P8_LOAD
    }
#if defined(MFMA_PROBE_CUS)
    if (IN(8)) { GRID_BAR();
        if (bx < MFMA_PROBE_CUS) {
            typedef float f32x16_ __attribute__((ext_vector_type(16))); typedef short bf16x8_ __attribute__((ext_vector_type(8)));
            f32x16_ a0 = {}, a1 = {}, a2 = {}, a3 = {}; bf16x8_ x = {1, 2, 3, 4, 5, 6, 7, 8}, y = {8, 7, 6, 5, 4, 3, 2, 1}; asm volatile("" : "+v"(x), "+v"(y));
            for (int it = 0; it < MFMA_PROBE_N / 4; ++it) {
                a0 = __builtin_amdgcn_mfma_f32_32x32x16_bf16(x, y, a0, 0, 0, 0); a1 = __builtin_amdgcn_mfma_f32_32x32x16_bf16(x, y, a1, 0, 0, 0);
                a2 = __builtin_amdgcn_mfma_f32_32x32x16_bf16(x, y, a2, 0, 0, 0); a3 = __builtin_amdgcn_mfma_f32_32x32x16_bf16(x, y, a3, 0, 0, 0); }
            const f32x16_ s = a0 + a1 + a2 + a3; float t = 0.f;
#pragma unroll
            for (int r = 0; r < 16; ++r) t += s[r];
            if (t == 12345.678f) ((float*)(args.ws + WS_CTL))[2048] = t;
        }
    }
#endif
#undef IN
#undef BOTH
#undef GRID_BAR
}

extern "C" void kernel_launch(void* const* d_in, const int* in_sizes, int n_in, void* d_out, int out_size, void* d_ws, size_t ws_size, hipStream_t stream) {
    static int grid = 0;
    if (grid == 0) {
        if (n_in != 20 || (size_t)out_size != OUT_TOTAL || ws_size < WS_END) { fprintf(stderr, "kernel_launch: shape mismatch (n_in %d, out %d want %zu, ws %zu want %zu); nothing launched\n", n_in, out_size, (size_t)OUT_TOTAL, ws_size, (size_t)WS_END); grid = -1; return; }
        int dev = 0, cus = 0, per_cu = 0;
        if (hipGetDevice(&dev) != hipSuccess || hipDeviceGetAttribute(&cus, hipDeviceAttributeMultiprocessorCount, dev) != hipSuccess) { fprintf(stderr, "kernel_launch: device query failed\n"); grid = -1; return; }
        if (hipFuncSetAttribute((const void*)yoco_fwd, hipFuncAttributeMaxDynamicSharedMemorySize, LDS_BYTES) != hipSuccess) { fprintf(stderr, "kernel_launch: hipFuncSetAttribute failed\n"); grid = -1; return; }
        if (hipOccupancyMaxActiveBlocksPerMultiprocessor(&per_cu, (const void*)yoco_fwd, NWAVES * 64, LDS_BYTES) != hipSuccess || per_cu < 1)
            fprintf(stderr, "kernel_launch: note: occupancy query reports %d workgroups per CU\n", per_cu);
        (void)hipGetLastError();
        grid = cus;
        if (grid != 256) fprintf(stderr, "kernel_launch: note: %d CUs (the static work deals assume 256)\n", grid);
    }
    if (grid < 0) return;
    if (hipMemsetAsync((char*)d_ws + WS_CTL, 0, CTL_ZERO_BYTES, stream) != hipSuccess) { fprintf(stderr, "kernel_launch: hipMemsetAsync failed\n"); return; }
    Args a{};
    for (int i = 0; i < 20; ++i) a.in[i] = (const float*)d_in[i];
    a.out = (float*)d_out; a.ws = (unsigned char*)d_ws;
    for (int li = 0; li < N_LAUNCHES; ++li) {
        if (N_LAUNCHES == 1) { a.ph_lo = 0; a.ph_hi = N_PHASES; } else { a.ph_lo = li * N_PHASES / N_LAUNCHES; a.ph_hi = (li + 1) * N_PHASES / N_LAUNCHES; }
        hipLaunchKernelGGL(yoco_fwd, dim3(grid), dim3(NWAVES * 64), LDS_BYTES, stream, a);
        const hipError_t le = hipPeekAtLastError();
        if (le != hipSuccess) { fprintf(stderr, "kernel_launch: launch %d failed: %s\n", li, hipGetErrorName(le)); break; }
    }
}
```
